# Optimizing an MI355X kernel written in HIP

```python
import math
import jax, jax.numpy as jnp
from jax import lax
import numpy as np

D_MODEL = 1024
BATCH = 32
SEQ = 256
DEPTH = 2
DEC_BATCH = 2
DEC_SEQ = 4096
PAST_LEN = 512

GRID_W = 64
POS_BASE = 10000.0
EPS = 1e-6
D_FF = 4 * D_MODEL
MIX_WIDTH = D_MODEL
N_MOD = 6

S5_CH = 3 * MIX_WIDTH // 4
S5_GROUP = 16
S5_GROUPS = S5_CH // S5_GROUP
S5_STATE = 64
DT_MIN = 1e-3
DT_MAX = 1e-1
FNET_CH = MIX_WIDTH - S5_CH
FNET_GROUPS = 4
FNET_GW = FNET_CH // FNET_GROUPS

POOL_WINDOWS = (2, 4, 8, 16)
POOL_GROUPS = len(POOL_WINDOWS)
POOL_CH = MIX_WIDTH // 2
POOL_GW = POOL_CH // POOL_GROUPS
GMLP_CH = MIX_WIDTH - POOL_CH
GMLP_HEADS = 4
GMLP_HD = GMLP_CH // GMLP_HEADS
GMLP_CHUNK = 128

kernel_name = "hybrid_s5_fnet_pool_gmlp_diffusion_step"

F32 = jnp.float32


def rmsnorm(x, g):
    xf = x.astype(F32)
    y = xf * lax.rsqrt(jnp.mean(xf * xf, axis=-1, keepdims=True) + EPS)
    return (y * g.astype(F32)).astype(x.dtype)


def group_layernorm(v, g, b, groups):
    bt, l, cn = v.shape
    vf = v.astype(F32).reshape(bt, l, groups, cn // groups)
    mu = jnp.mean(vf, axis=-1, keepdims=True)
    var = jnp.mean(jnp.square(vf - mu), axis=-1, keepdims=True)
    y = ((vf - mu) * lax.rsqrt(var + EPS)).reshape(bt, l, cn)
    return (y * g.astype(F32) + b.astype(F32)).astype(v.dtype)


def grid_pos_embed(length, dtype):
    rows = length // GRID_W
    rr, cc = jnp.meshgrid(jnp.arange(rows, dtype=F32), jnp.arange(GRID_W, dtype=F32), indexing="ij")
    quarter = D_MODEL // 4
    omega = 1.0 / (POS_BASE ** (jnp.arange(quarter, dtype=F32) / quarter))

    def axis_embed(p):
        ang = p.reshape(-1)[:, None] * omega[None, :]
        return jnp.concatenate([jnp.sin(ang), jnp.cos(ang)], axis=-1)

    return jnp.concatenate([axis_embed(rr), axis_embed(cc)], axis=-1).astype(dtype)


def modulation(cond, w_mod, b_mod):
    m = jax.nn.silu(cond) @ w_mod + b_mod
    return jnp.split(m[:, None, :], N_MOD, axis=-1)


def sq_relu_mlp(h, w1, w2):
    return jnp.square(jax.nn.relu(h @ w1)) @ w2


def s5_discretize(lam_re, lam_im, log_dt, b_re, b_im):
    dt = jnp.exp(log_dt)[:, None]
    mag = jnp.exp(lam_re * dt)
    ab_re = mag * jnp.cos(lam_im * dt)
    ab_im = mag * jnp.sin(lam_im * dt)
    num_re = ab_re - 1.0
    num_im = ab_im
    den = lam_re * lam_re + lam_im * lam_im
    coef_re = (num_re * lam_re + num_im * lam_im) / den
    coef_im = (num_im * lam_re - num_re * lam_im) / den
    bb_re = coef_re[..., None] * b_re - coef_im[..., None] * b_im
    bb_im = coef_re[..., None] * b_im + coef_im[..., None] * b_re
    return ab_re, ab_im, bb_re, bb_im


def _complex_linear_combine(e1, e2):
    a1r, a1i, b1r, b1i = e1
    a2r, a2i, b2r, b2i = e2
    return (a2r * a1r - a2i * a1i,
            a2r * a1i + a2i * a1r,
            a2r * b1r - a2i * b1i + b2r,
            a2r * b1i + a2i * b1r + b2i)


def s5_direction(u, h0_re, h0_im, lam_re, lam_im, log_dt, b_re, b_im, c_re, c_im):
    ab_re, ab_im, bb_re, bb_im = s5_discretize(lam_re, lam_im, log_dt, b_re, b_im)
    bu_re = jnp.einsum("blgh,gph->blgp", u, bb_re)
    bu_im = jnp.einsum("blgh,gph->blgp", u, bb_im)
    bu_re = bu_re.at[:, 0].add(ab_re * h0_re - ab_im * h0_im)
    bu_im = bu_im.at[:, 0].add(ab_re * h0_im + ab_im * h0_re)
    a_re = jnp.broadcast_to(ab_re, bu_re.shape)
    a_im = jnp.broadcast_to(ab_im, bu_im.shape)
    _, _, h_re, h_im = lax.associative_scan(_complex_linear_combine, (a_re, a_im, bu_re, bu_im), axis=1)
    y = jnp.einsum("blgp,ghp->blgh", h_re, c_re) - jnp.einsum("blgp,ghp->blgh", h_im, c_im)
    return y, h_re[:, -1], h_im[:, -1]


def s5_mixer(u, h0_re, h0_im, lam_re, lam_im, log_dt, b_re, b_im, c_re, c_im, d, w_glu, b_glu):
    bt, l, _ = u.shape
    lam_re, lam_im, log_dt, b_re, b_im, c_re, c_im, d = (
        a.astype(F32) for a in (lam_re, lam_im, log_dt, b_re, b_im, c_re, c_im, d))
    h0_re = h0_re.astype(F32)
    h0_im = h0_im.astype(F32)
    uf = u.astype(F32).reshape(bt, l, S5_GROUPS, S5_GROUP)
    y_f, hf_re, hf_im = s5_direction(uf, h0_re[:, 0], h0_im[:, 0], lam_re[0], lam_im[0], log_dt[0],
                                     b_re[0], b_im[0], c_re[0], c_im[0])
    y_b, hb_re, hb_im = s5_direction(jnp.flip(uf, 1), h0_re[:, 1], h0_im[:, 1], lam_re[1], lam_im[1], log_dt[1],
                                     b_re[1], b_im[1], c_re[1], c_im[1])
    y = (y_f + jnp.flip(y_b, 1)).reshape(bt, l, S5_CH) + d * uf.reshape(bt, l, S5_CH)
    g = jax.nn.gelu(y)
    out = g * jax.nn.sigmoid(g @ w_glu.astype(F32) + b_glu.astype(F32))
    s_re = jnp.stack([hf_re, hb_re], axis=1)
    s_im = jnp.stack([hf_im, hb_im], axis=1)
    return out.astype(u.dtype), s_re, s_im


def fnet_mixer(u, w, b):
    bt, l, _ = u.shape
    uf = u.astype(F32).reshape(bt, l, FNET_GROUPS, FNET_GW)
    z = jnp.fft.fft2(uf, axes=(1, 3), norm="ortho").real.astype(u.dtype)
    out = jnp.einsum("blgc,gcd->blgd", z, w) + b
    return out.reshape(bt, l, FNET_CH)


def pool_mixer(u, w, scale):
    bt, l, _ = u.shape
    uf = u.astype(F32).reshape(bt, l, POOL_GROUPS, POOL_GW)
    cs = jnp.concatenate([jnp.zeros((bt, 1, POOL_GROUPS, POOL_GW), F32), jnp.cumsum(uf, axis=1)], axis=1)
    t = jnp.arange(l)
    pooled = []
    for gi, win in enumerate(POOL_WINDOWS):
        lo = jnp.clip(t - win // 2, 0, l)
        hi = jnp.clip(t + win // 2, 0, l)
        s = cs[:, hi, gi] - cs[:, lo, gi]
        pooled.append(s / (hi - lo).astype(F32)[None, :, None])
    p = (jnp.stack(pooled, axis=2) - uf).astype(u.dtype)
    mixed = jnp.einsum("blgc,gcd->blgd", p, w).reshape(bt, l, POOL_CH)
    return mixed * scale


def gmlp_mixer(uv, ln_g, ln_b, ws, bs):
    bt, l, _ = uv.shape
    z = jax.nn.gelu(uv)
    u, v = jnp.split(z, 2, axis=-1)
    v = group_layernorm(v, ln_g, ln_b, GMLP_HEADS)
    n_chunks = l // GMLP_CHUNK
    vh = v.reshape(bt, n_chunks, GMLP_CHUNK, GMLP_HEADS, GMLP_HD)
    sv = jnp.einsum("bnkhd,hqk->bnqhd", vh, ws) + bs.T[:, :, None]
    return u * sv.reshape(bt, l, GMLP_CH)


def even_mixer(h, h0_re, h0_im, w_in, w_out, lam_re, lam_im, log_dt, b_re, b_im, c_re, c_im, d,
               w_glu, b_glu, fnet_w, fnet_b):
    z = h @ w_in
    ya, s_re, s_im = s5_mixer(z[..., :S5_CH], h0_re, h0_im, lam_re, lam_im, log_dt, b_re, b_im,
                              c_re, c_im, d, w_glu, b_glu)
    yb = fnet_mixer(z[..., S5_CH:], fnet_w, fnet_b)
    return jnp.concatenate([ya, yb], axis=-1) @ w_out, (s_re, s_im)


def odd_mixer(h, w_in, w_out, pool_w, pool_scale, ln_g, ln_b, ws, bs):
    z = h @ w_in
    yc = pool_mixer(z[..., :POOL_CH], pool_w, pool_scale)
    yd = gmlp_mixer(z[..., POOL_CH:], ln_g, ln_b, ws, bs)
    return jnp.concatenate([yc, yd], axis=-1) @ w_out, ()


def run_layer(x, cond, mixer, w_mod, b_mod, g_mix_pre, g_mix_post, g_ff_pre, g_ff_post, w_ff1, w_ff2):
    sh1, sc1, gt1, sh2, sc2, gt2 = modulation(cond, w_mod, b_mod)
    h = rmsnorm(x, g_mix_pre) * (1.0 + sc1) + sh1
    y, aux = mixer(h)
    x = x + gt1 * rmsnorm(y, g_mix_post)
    h = rmsnorm(x, g_ff_pre) * (1.0 + sc2) + sh2
    x = x + gt2 * rmsnorm(sq_relu_mlp(h, w_ff1, w_ff2), g_ff_post)
    return x, aux


def setup_inputs(seed: int = 0) -> dict:
    key = jax.random.key(seed)
    ks = iter(jax.random.split(key, 80))

    def nrm(shape, scale=1.0):
        return jax.random.normal(next(ks), shape, F32) * scale

    def gain(shape):
        return 1.0 + nrm(shape, 0.05)

    inp = {}
    inp["x_prompt"] = nrm((BATCH, SEQ, D_MODEL))
    inp["x_sample"] = nrm((DEC_BATCH, DEC_SEQ, D_MODEL))
    inp["state_l0_s5_re"] = nrm((DEC_BATCH, 2, S5_GROUPS, S5_STATE), 0.1)
    inp["state_l0_s5_im"] = nrm((DEC_BATCH, 2, S5_GROUPS, S5_STATE), 0.1)
    inp["c"] = nrm((DEC_BATCH, D_MODEL))
    inp["c_ctx"] = nrm((D_MODEL,))
    for li in range(DEPTH):
        p = "l%d_" % li
        inp[p + "w_mod"] = nrm((D_MODEL, N_MOD * D_MODEL), 0.5 * D_MODEL ** -0.5)
        inp[p + "b_mod"] = nrm((N_MOD * D_MODEL,), 0.02)
        inp[p + "g_mix_pre"] = gain((D_MODEL,))
        inp[p + "g_mix_post"] = gain((D_MODEL,))
        inp[p + "g_ff_pre"] = gain((D_MODEL,))
        inp[p + "g_ff_post"] = gain((D_MODEL,))
        inp[p + "w_ff1"] = nrm((D_MODEL, D_FF), D_MODEL ** -0.5)
        inp[p + "w_ff2"] = nrm((D_FF, D_MODEL), D_FF ** -0.5)
        if li % 2 == 0:
            inp[p + "w_in"] = nrm((D_MODEL, MIX_WIDTH), D_MODEL ** -0.5)
            inp[p + "w_out"] = nrm((MIX_WIDTH, D_MODEL), MIX_WIDTH ** -0.5)
            n_idx = jnp.arange(S5_STATE, dtype=F32)
            inp[p + "s5_lambda_re"] = -0.5 + nrm((2, S5_GROUPS, S5_STATE), 0.01)
            inp[p + "s5_lambda_im"] = math.pi * n_idx + nrm((2, S5_GROUPS, S5_STATE), 0.01)
            inp[p + "s5_log_dt"] = jax.random.uniform(next(ks), (2, S5_GROUPS), F32,
                                                      math.log(DT_MIN), math.log(DT_MAX))
            inp[p + "s5_b_re"] = nrm((2, S5_GROUPS, S5_STATE, S5_GROUP), (2 * S5_GROUP) ** -0.5)
            inp[p + "s5_b_im"] = nrm((2, S5_GROUPS, S5_STATE, S5_GROUP), (2 * S5_GROUP) ** -0.5)
            inp[p + "s5_c_re"] = nrm((2, S5_GROUPS, S5_GROUP, S5_STATE), (2 * S5_STATE) ** -0.5)
            inp[p + "s5_c_im"] = nrm((2, S5_GROUPS, S5_GROUP, S5_STATE), (2 * S5_STATE) ** -0.5)
            inp[p + "s5_d"] = nrm((S5_CH,))
            inp[p + "s5_w_glu"] = nrm((S5_CH, S5_CH), S5_CH ** -0.5)
            inp[p + "s5_b_glu"] = nrm((S5_CH,), 0.02)
            inp[p + "fnet_w"] = nrm((FNET_GROUPS, FNET_GW, FNET_GW), FNET_GW ** -0.5)
            inp[p + "fnet_b"] = nrm((FNET_GROUPS, FNET_GW), 0.02)
        else:
            inp[p + "w_in"] = nrm((D_MODEL, POOL_CH + 2 * GMLP_CH), D_MODEL ** -0.5)
            inp[p + "w_out"] = nrm((MIX_WIDTH, D_MODEL), MIX_WIDTH ** -0.5)
            inp[p + "pool_w"] = nrm((POOL_GROUPS, POOL_GW, POOL_GW), POOL_GW ** -0.5)
            inp[p + "pool_scale"] = 1.0 + nrm((POOL_CH,), 0.1)
            inp[p + "gmlp_ln_g"] = gain((GMLP_CH,))
            inp[p + "gmlp_ln_b"] = nrm((GMLP_CH,), 0.02)
            inp[p + "gmlp_ws"] = nrm((GMLP_HEADS, GMLP_CHUNK, GMLP_CHUNK), GMLP_CHUNK ** -0.5)
            inp[p + "gmlp_bs"] = 1.0 + nrm((GMLP_HEADS, GMLP_CHUNK), 0.1)
    return inp


def reference(x_prompt, x_sample, state_l0_s5_re, state_l0_s5_im, c, c_ctx,
              l0_w_mod, l0_b_mod, l0_g_mix_pre, l0_g_mix_post, l0_g_ff_pre, l0_g_ff_post, l0_w_ff1, l0_w_ff2,
              l0_w_in, l0_w_out, l0_s5_lambda_re, l0_s5_lambda_im, l0_s5_log_dt, l0_s5_b_re, l0_s5_b_im,
              l0_s5_c_re, l0_s5_c_im, l0_s5_d, l0_s5_w_glu, l0_s5_b_glu, l0_fnet_w, l0_fnet_b,
              l1_w_mod, l1_b_mod, l1_g_mix_pre, l1_g_mix_post, l1_g_ff_pre, l1_g_ff_post, l1_w_ff1, l1_w_ff2,
              l1_w_in, l1_w_out, l1_pool_w, l1_pool_scale, l1_gmlp_ln_g, l1_gmlp_ln_b, l1_gmlp_ws, l1_gmlp_bs):
    common = (
        (l0_w_mod, l0_b_mod, l0_g_mix_pre, l0_g_mix_post, l0_g_ff_pre, l0_g_ff_post, l0_w_ff1, l0_w_ff2),
        (l1_w_mod, l1_b_mod, l1_g_mix_pre, l1_g_mix_post, l1_g_ff_pre, l1_g_ff_post, l1_w_ff1, l1_w_ff2),
    )
    even_params = (l0_w_in, l0_w_out, l0_s5_lambda_re, l0_s5_lambda_im, l0_s5_log_dt, l0_s5_b_re, l0_s5_b_im,
                   l0_s5_c_re, l0_s5_c_im, l0_s5_d, l0_s5_w_glu, l0_s5_b_glu, l0_fnet_w, l0_fnet_b)
    odd_params = (l1_w_in, l1_w_out, l1_pool_w, l1_pool_scale, l1_gmlp_ln_g, l1_gmlp_ln_b, l1_gmlp_ws, l1_gmlp_bs)

    def trunk(x, cond, h0_re, h0_im):
        states = []
        for i in range(DEPTH):
            if i % 2 == 0:
                mixer = lambda h: even_mixer(h, h0_re, h0_im, *even_params)
            else:
                mixer = lambda h: odd_mixer(h, *odd_params)
            x, aux = run_layer(x, cond, mixer, *common[i])
            states.extend(aux)
        return x, states

    zero_state = jnp.zeros((x_prompt.shape[0], 2, S5_GROUPS, S5_STATE), F32)
    y_prompt, ctx_states = trunk(x_prompt, c_ctx[None, :], zero_state, zero_state)
    new_l0_s5_re = ctx_states[0].astype(x_prompt.dtype)
    new_l0_s5_im = ctx_states[1].astype(x_prompt.dtype)

    xs = x_sample + grid_pos_embed(x_sample.shape[1], x_sample.dtype)[None]
    y_sample, _ = trunk(xs, c, state_l0_s5_re, state_l0_s5_im)

    return (y_prompt, y_sample, new_l0_s5_re, new_l0_s5_im)
```

```cpp
#include <hip/hip_runtime.h>
#include <hip/hip_cooperative_groups.h>
#include <cstdio>
namespace cg = cooperative_groups;
#define REP_P0 1
#define REP_P1 1
#define REP_FF1 1
#define REP_FF2 1
#define EXTRA_SYNC 0

#define LAS __attribute__((address_space(3)))
typedef unsigned short bf16_t;
typedef short bf16x8 __attribute__((ext_vector_type(8)));
typedef float f32x4 __attribute__((ext_vector_type(4)));
typedef float f32x2 __attribute__((ext_vector_type(2)));
typedef unsigned u32x4 __attribute__((ext_vector_type(4)));
typedef unsigned u32x2 __attribute__((ext_vector_type(2)));

constexpr int NTOK = 16384, DM = 1024, NPR = 8192, DFF = 4096;
constexpr float EPS = 1e-6f;
constexpr int LDS_BYTES = 131072 + 16;
constexpr size_t MiB = 1048576;
constexpr size_t WS_WFF1 = 0;
constexpr size_t WS_WFF2 = WS_WFF1 + 8 * MiB;
constexpr size_t WS_WIN0 = WS_WFF2 + 8 * MiB;
constexpr size_t WS_WGLU = WS_WIN0 + 2 * MiB;
constexpr size_t WS_WOUT0 = WS_WGLU + 1179648;
constexpr size_t WS_WIN1 = WS_WOUT0 + 2621440;
constexpr size_t WS_WOUT1 = WS_WIN1 + 3 * MiB;
constexpr size_t WS_ME = WS_WOUT1 + 2 * MiB;
constexpr size_t WS_SG = WS_ME + 12 * MiB;
constexpr size_t WS_D512 = WS_SG + 6 * MiB;
constexpr size_t WS_A2 = WS_D512 + 524288;
constexpr size_t WS_MOD = WS_A2 + 262144;
constexpr size_t WS_APOW = WS_MOD + 147456;
constexpr size_t WS_BBT = WS_APOW + 835584;
constexpr size_t WS_KTAB = WS_BBT + 786432;
constexpr size_t WS_CSW = WS_KTAB + 1572864;
constexpr size_t WS_BIAS0 = WS_CSW + 131072;
constexpr size_t WS_HY = WS_BIAS0 + 4096;
constexpr size_t WS_MIX = WS_HY + 32 * MiB;
constexpr size_t WS_BIG = WS_MIX + 40 * MiB;
constexpr size_t WS_UH = WS_BIG;
constexpr size_t WS_SLOC = WS_BIG + 48 * MiB;
constexpr size_t WS_G = WS_HY;
constexpr size_t WS_ZT = WS_BIG + 96 * MiB;
constexpr size_t WS_YT = WS_BIG + 104 * MiB;
constexpr size_t WS_ZUV = WS_BIG;
constexpr size_t WS_VT = WS_BIG + 48 * MiB;
constexpr size_t WS_HMID = WS_BIG;
constexpr size_t WS_BAR = WS_BIG + 128 * MiB;
constexpr size_t WS_CNT = WS_BAR + 16384;
constexpr size_t WS_SLOT = WS_CNT + 32768;
constexpr size_t WS_END = WS_SLOT + 2 * 262144;
constexpr size_t WS_ZERO_BYTES = 16384 + 32768;

struct Params { const float* in[44]; float* out; unsigned char* ws; };
#define PIN(k) ([&]() -> const float* { int k_ = (k); asm volatile("" : "+s"(k_)); return p.in[k_]; }())

__device__ __forceinline__ unsigned pk2(float lo, float hi) { unsigned r; asm("v_cvt_pk_bf16_f32 %0, %1, %2" : "=v"(r) : "v"(lo), "v"(hi)); return r; }
__device__ __forceinline__ bf16_t f2bf(float f) { return (bf16_t)(pk2(f, 0.f) & 0xffffu); }
__device__ __forceinline__ float bf2f(bf16_t b) { return __uint_as_float(((unsigned)b) << 16); }
__device__ __forceinline__ float bflo(unsigned w) { return __uint_as_float(w << 16); }
__device__ __forceinline__ float bfhi(unsigned w) { return __uint_as_float(w & 0xffff0000u); }
__device__ __forceinline__ float fexp(float x) { return __builtin_amdgcn_exp2f(x * 1.4426950408889634f); }
__device__ __forceinline__ float sigm(float x) { return __builtin_amdgcn_rcpf(1.f + fexp(-x)); }
__device__ __forceinline__ float gelu_t(float x) { const float u = 0.7978845608028654f * (x + 0.044715f * x * x * x); return x * sigm(2.f * u); }
__device__ __forceinline__ void sincos_rev(float rev, float& s, float& c) { const float f = rev - floorf(rev); s = __builtin_amdgcn_sinf(f); c = __builtin_amdgcn_cosf(f); }
__device__ __forceinline__ float wave_sum(float v) {
    v += __int_as_float(__builtin_amdgcn_ds_swizzle(__float_as_int(v), 0x041f));
    v += __int_as_float(__builtin_amdgcn_ds_swizzle(__float_as_int(v), 0x081f));
    v += __int_as_float(__builtin_amdgcn_ds_swizzle(__float_as_int(v), 0x101f));
    v += __int_as_float(__builtin_amdgcn_ds_swizzle(__float_as_int(v), 0x201f));
    v += __int_as_float(__builtin_amdgcn_ds_swizzle(__float_as_int(v), 0x401f));
    return __int_as_float(__builtin_amdgcn_readlane(__float_as_int(v), 0)) + __int_as_float(__builtin_amdgcn_readlane(__float_as_int(v), 32));
}
#define LDS_WAIT() asm volatile("s_waitcnt lgkmcnt(0)" ::: "memory")
__device__ __forceinline__ int tid_fresh(int wv) { unsigned z = 0u; asm volatile("" : "+v"(z)); return wv * 64 + (int)__builtin_amdgcn_mbcnt_hi(~0u, __builtin_amdgcn_mbcnt_lo(~0u, z)); }


#define XB_TMO      128
#define XB_XCNT(j)  (256  + 64 * (j))
#define XB_XSUB(j)  (1280 + 64 * (j))
#define XB_XGEN(j)  (2304 + 64 * (j))
#define XB_TOP      3328
#define XB_TOPGEN   3392
#define XCD_BAR_WORDS 3456
#define XB_SPIN_CAP (1u << 18)
__device__ __forceinline__ unsigned xb_ld(unsigned* p)              { return __hip_atomic_load(p, __ATOMIC_RELAXED, __HIP_MEMORY_SCOPE_AGENT); }
__device__ __forceinline__ unsigned xb_add(unsigned* p, unsigned v) { return __hip_atomic_fetch_add(p, v, __ATOMIC_RELAXED, __HIP_MEMORY_SCOPE_AGENT); }
__device__ __forceinline__ unsigned xb_xcc_id() { return (unsigned)__builtin_amdgcn_s_getreg((3 << 11) | 20) & 0xFu; }
#define XB_SPIN(cond, bar) do { unsigned _sp = 0; while (cond) { __builtin_amdgcn_s_sleep(1); \
    if ((++_sp & 255u) == 0u) { if (xb_ld(&(bar)[XB_TMO])) break; if (_sp > XB_SPIN_CAP) { atomicAdd(&(bar)[XB_TMO], 1u); break; } } } } while (0)
__device__ __forceinline__ void xcd_barrier_complete(unsigned* bar, unsigned x, unsigned& nloc, unsigned& nx) {
    const unsigned G = gridDim.x * gridDim.y * gridDim.z;
    unsigned sum, cnt, mine, sp = 0u;
    for (;;) {
        sum = 0u; cnt = 0u; mine = 0u;
#pragma unroll
        for (unsigned j = 0; j < 16; ++j) { const unsigned c = xb_ld(&bar[XB_XCNT(j)]); sum += c; cnt += (c > 0u) ? 1u : 0u; mine = (j == x) ? c : mine; }
        if (sum == G) break;
        __builtin_amdgcn_s_sleep(1);
        if ((++sp & 255u) == 0u) { if (xb_ld(&bar[XB_TMO])) break; if (sp > XB_SPIN_CAP) { atomicAdd(&bar[XB_TMO], 1u); break; } }
    }
    nloc = mine > 0u ? mine : 1u; nx = cnt > 0u ? cnt : 1u;
}
__device__ __forceinline__ void xcd_barrier(unsigned* bar, volatile LAS unsigned* st, int wv) {
    asm volatile("s_waitcnt vmcnt(0)" ::: "memory");
    __syncthreads();
    if (tid_fresh(wv) == 0) {
        const unsigned x = xb_xcc_id();
        __builtin_amdgcn_s_waitcnt(0);
        unsigned nloc = st[0], nx = st[1];
        if (nloc == 0u) { xcd_barrier_complete(bar, x, nloc, nx); st[0] = nloc; st[1] = nx; }
        const unsigned old = xb_add(&bar[XB_XSUB(x)], 1u);
        const unsigned gen = old / nloc;
        if (old + 1u == (gen + 1u) * nloc) {
            __builtin_amdgcn_fence(__ATOMIC_RELEASE, "agent");
            asm volatile("s_waitcnt vmcnt(0)" ::: "memory");
            const unsigned og = xb_add(&bar[XB_TOP], 1u);
            const unsigned tg = og / nx;
            if (og + 1u == (tg + 1u) * nx) xb_add(&bar[XB_TOPGEN], 1u);
            else XB_SPIN(xb_ld(&bar[XB_TOPGEN]) == tg, bar);
            __builtin_amdgcn_fence(__ATOMIC_ACQUIRE, "agent");
            xb_add(&bar[XB_XGEN(x)], 1u);
            asm volatile("s_waitcnt vmcnt(0)" ::: "memory");
        } else {
            XB_SPIN(xb_ld(&bar[XB_XGEN(x)]) == gen, bar);
            __builtin_amdgcn_fence(__ATOMIC_ACQUIRE, "agent");
            asm volatile("s_waitcnt vmcnt(0)" ::: "memory");
        }
    }
    __syncthreads();
}

constexpr int BM = 256, BK = 64, HALF = 128, HTB = HALF * BK * 2;
__device__ __forceinline__ int lds_byte(int r, int c) { const int st = (r >> 4) * 2 + (c >> 5), rr = r & 15, cc = c & 31, ob = rr * 64 + cc * 2; return st * 1024 + (ob ^ (((ob >> 9) & 1) << 5)); }
__device__ __forceinline__ void stage_rc(int b, int& R, int& C) { const int st = b / 1024, sb = b % 1024, swz = sb ^ (((sb >> 9) & 1) << 5); R = (st >> 1) * 16 + swz / 64; C = (st & 1) * 32 + (swz % 64) / 2; }

__device__ __forceinline__ int perm32(int rho) { const int n = rho >> 4, i = rho & 15; return 8 * (i >> 2) + 4 * n + (i & 3); }
template <class E> struct EpiPerm { static constexpr bool v = false; };
template <int LDA, int LDB, int KK, int NM, int NN, int NBATCH, long SA, long SB>
struct GJob { const bf16_t* A; const bf16_t* B; static constexpr int lda = LDA, ldb = LDB, K = KK, nM = NM, nN = NN, nB = NBATCH; static constexpr long sA = SA, sB = SB; };
struct Unit { int b, pm, pn; };
template <class J>
__device__ __forceinline__ bool unit_at(const J& g, int u, Unit& o) {
    const int per = g.nM * g.nN, nwg = per * g.nB;
    if (u >= nwg) return false;
    int wgid = u; { const int q = nwg / 8, r = nwg % 8, xcd = wgid % 8, off = wgid / 8; wgid = (xcd < r ? xcd * (q + 1) : r * (q + 1) + (xcd - r) * q) + off; }
    o.b = wgid / per; const int w = wgid % per;
    const int nig = 4 * g.nN, gid = w / nig, fm = gid * 4, gsz = (g.nM - fm) < 4 ? (g.nM - fm) : 4;
    o.pm = fm + ((w % nig) % gsz); o.pn = (w % nig) / gsz; return true;
}

#define EPI_LOOP(...) \
    _Pragma("unroll") for (int ai = 0; ai < 2; ++ai) _Pragma("unroll") for (int m = 0; m < 4; ++m) { const int row = u.pm * 256 + ai * 128 + wr * 64 + m * 16 + fr; \
    _Pragma("unroll") for (int bj = 0; bj < 2; ++bj) _Pragma("unroll") for (int n = 0; n < 2; ++n) { const int col = u.pn * 256 + bj * 128 + wc * 32 + n * 16 + 4 * fq; const f32x4 v = acc[ai][bj][m][n]; __VA_ARGS__ } }
#define EPI_SIG const f32x4 (&acc)[2][2][4][2], const Unit& u, int wr, int wc, int fr, int fq

__device__ __forceinline__ void st_bf4(bf16_t* p, f32x4 v) { u32x2 w; w.x = pk2(v[0], v[1]); w.y = pk2(v[2], v[3]); *(u32x2*)p = w; }

struct EpiU {
    static constexpr bool AFTER_DRAIN = false;
    bf16_t* UH;
    __device__ __forceinline__ void operator()(EPI_SIG) const {
#pragma unroll
        for (int ai = 0; ai < 2; ++ai)
#pragma unroll
            for (int m = 0; m < 4; ++m) { const int row = u.pm * 256 + ai * 128 + wr * 64 + m * 16 + fr;
#pragma unroll
                for (int bj = 0; bj < 2; ++bj) { const int col = u.pn * 256 + bj * 128 + wc * 32 + 8 * fq, g = col >> 4, h = col & 15;
                    const f32x4 a = acc[ai][bj][m][0], b = acc[ai][bj][m][1];
                    u32x4 w; w.x = pk2(a[0], a[1]); w.y = pk2(a[2], a[3]); w.z = pk2(b[0], b[1]); w.w = pk2(b[2], b[3]);
                    *(u32x4*)(UH + ((size_t)g * 1024 + (row >> 4)) * 512 + (row & 15) * 16 + h) = w; } }
    }
};
template <> struct EpiPerm<EpiU> { static constexpr bool v = true; };
struct EpiZt {
    static constexpr bool AFTER_DRAIN = false;
    bf16_t* ZT;
    __device__ __forceinline__ void operator()(EPI_SIG) const { EPI_LOOP(
        const size_t off = (col < NPR) ? ((size_t)(col >> 8) * 65536 + (size_t)row * 256 + (col & 255)) : ((size_t)32 * 65536 + (size_t)((col - NPR) >> 12) * (256 * 4096) + (size_t)row * 4096 + ((col - NPR) & 4095));
        st_bf4(ZT + off, v); ) }
};
struct EpiState {
    static constexpr bool AFTER_DRAIN = false;
    float* S;
    __device__ __forceinline__ void operator()(EPI_SIG) const { EPI_LOOP( *(f32x4*)(S + ((size_t)u.b * 1024 + row) * 256 + col) = v; ) }
};
struct EpiY {
    static constexpr bool AFTER_DRAIN = false;
    bf16_t* G;
    __device__ __forceinline__ void operator()(EPI_SIG) const {
#pragma unroll
        for (int ai = 0; ai < 2; ++ai)
#pragma unroll
            for (int m = 0; m < 4; ++m) { const int row = u.pm * 256 + ai * 128 + wr * 64 + m * 16 + fr;
#pragma unroll
                for (int bj = 0; bj < 2; ++bj) { const int col = u.pn * 256 + bj * 128 + wc * 32 + 8 * fq;
                    const f32x4 a = acc[ai][bj][m][0], b = acc[ai][bj][m][1];
                    u32x4 w; w.x = pk2(gelu_t(a[0]), gelu_t(a[1])); w.y = pk2(gelu_t(a[2]), gelu_t(a[3])); w.z = pk2(gelu_t(b[0]), gelu_t(b[1])); w.w = pk2(gelu_t(b[2]), gelu_t(b[3]));
                    *(u32x4*)(G + (size_t)(row * 16 + (col >> 4)) * 768 + u.b * 16 + (col & 15)) = w; } }
    }
};
struct EpiGlu {
    static constexpr bool AFTER_DRAIN = false;
    const bf16_t* G; const float* bglu; bf16_t* MIX;
    __device__ __forceinline__ void operator()(EPI_SIG) const {
        f32x4 bb[2][2];
#pragma unroll
        for (int bj = 0; bj < 2; ++bj) { const int col = u.pn * 256 + bj * 128 + wc * 32 + 8 * fq; bb[bj][0] = *(const f32x4*)(bglu + col); bb[bj][1] = *(const f32x4*)(bglu + col + 4); }
#pragma unroll
        for (int ai = 0; ai < 2; ++ai) {
            u32x4 gw[4][2];
#pragma unroll
            for (int m = 0; m < 4; ++m)
#pragma unroll
                for (int bj = 0; bj < 2; ++bj) { const int row = u.pm * 256 + ai * 128 + wr * 64 + m * 16 + fr, col = u.pn * 256 + bj * 128 + wc * 32 + 8 * fq;
                    gw[m][bj] = *(const u32x4*)(G + (size_t)row * 768 + col); }
#pragma unroll
            for (int m = 0; m < 4; ++m)
#pragma unroll
                for (int bj = 0; bj < 2; ++bj) { const int row = u.pm * 256 + ai * 128 + wr * 64 + m * 16 + fr, col = u.pn * 256 + bj * 128 + wc * 32 + 8 * fq;
                    const f32x4 a = acc[ai][bj][m][0], b = acc[ai][bj][m][1]; const u32x4 g4 = gw[m][bj];
                    u32x4 w; w.x = pk2(bflo(g4.x) * sigm(a[0] + bb[bj][0][0]), bfhi(g4.x) * sigm(a[1] + bb[bj][0][1])); w.y = pk2(bflo(g4.y) * sigm(a[2] + bb[bj][0][2]), bfhi(g4.y) * sigm(a[3] + bb[bj][0][3]));
                    w.z = pk2(bflo(g4.z) * sigm(b[0] + bb[bj][1][0]), bfhi(g4.z) * sigm(b[1] + bb[bj][1][1])); w.w = pk2(bflo(g4.w) * sigm(b[2] + bb[bj][1][2]), bfhi(g4.w) * sigm(b[3] + bb[bj][1][3]));
                    *(u32x4*)(MIX + (size_t)row * 1280 + col) = w; }
        }
    }
};
struct EpiDft {
    static constexpr bool AFTER_DRAIN = false;
    bf16_t* MIX; int sample; float scale;
    __device__ __forceinline__ void operator()(EPI_SIG) const { EPI_LOOP(
        const int cs = row >> 8, k2 = row & 255;
        const int token = sample ? (NPR + (u.b >> 4) * 4096 + (u.b & 15) + 16 * k2) : (u.b * 256 + k2);
        st_bf4(MIX + (size_t)token * 1280 + 768 + (col >> 6) * 128 + cs * 64 + (col & 63), v * scale); ) }
};
struct EpiPlain {
    static constexpr bool AFTER_DRAIN = false;
    bf16_t* O; int ld; const float* bias; int gelu_from;
    __device__ __forceinline__ void operator()(EPI_SIG) const {
        const bool dog = (u.pn * 256) >= gelu_from;
#pragma unroll
        for (int ai = 0; ai < 2; ++ai)
#pragma unroll
            for (int m = 0; m < 4; ++m) { const int row = u.pm * 256 + ai * 128 + wr * 64 + m * 16 + fr;
#pragma unroll
                for (int bj = 0; bj < 2; ++bj) { const int col = u.pn * 256 + bj * 128 + wc * 32 + 8 * fq;
                    f32x4 a = acc[ai][bj][m][0], b = acc[ai][bj][m][1];
                    if (dog) {
#pragma unroll
                        for (int e = 0; e < 4; ++e) { a[e] = gelu_t(a[e]); b[e] = gelu_t(b[e]); } }
                    u32x4 w; w.x = pk2(a[0], a[1]); w.y = pk2(a[2], a[3]); w.z = pk2(b[0], b[1]); w.w = pk2(b[2], b[3]);
                    *(u32x4*)(O + (size_t)row * ld + col) = w; } }
    }
};
struct EpiRelu2 {
    static constexpr bool AFTER_DRAIN = false;
    bf16_t* O;
    __device__ __forceinline__ void operator()(EPI_SIG) const {
#pragma unroll
        for (int ai = 0; ai < 2; ++ai)
#pragma unroll
            for (int m = 0; m < 4; ++m) { const int row = u.pm * 256 + ai * 128 + wr * 64 + m * 16 + fr;
#pragma unroll
                for (int bj = 0; bj < 2; ++bj) { const int col = u.pn * 256 + bj * 128 + wc * 32 + 8 * fq;
                    f32x4 a = acc[ai][bj][m][0], b = acc[ai][bj][m][1];
#pragma unroll
                    for (int e = 0; e < 4; ++e) { a[e] = fmaxf(a[e], 0.f); b[e] = fmaxf(b[e], 0.f); }
                    a = a * a; b = b * b;
                    u32x4 w; w.x = pk2(a[0], a[1]); w.y = pk2(a[2], a[3]); w.z = pk2(b[0], b[1]); w.w = pk2(b[2], b[3]);
                    *(u32x4*)(O + (size_t)row * DFF + col) = w; } }
    }
};
template <> struct EpiPerm<EpiRelu2> { static constexpr bool v = true; };
template <> struct EpiPerm<EpiPlain> { static constexpr bool v = true; };
template <> struct EpiPerm<EpiY> { static constexpr bool v = true; };
template <> struct EpiPerm<EpiGlu> { static constexpr bool v = true; };
struct EpiResNorm;
template <> struct EpiPerm<EpiResNorm> { static constexpr bool v = true; };
struct EpiGmlp {
    static constexpr bool AFTER_DRAIN = false;
    const bf16_t* ZUV; const float* bs; bf16_t* MIX;
    __device__ __forceinline__ void operator()(EPI_SIG) const {
#pragma unroll
        for (int ai = 0; ai < 2; ++ai) {
            const int head = u.b * 2 + ai;
#pragma unroll
            for (int mp = 0; mp < 2; ++mp) {
                u32x2 uw[2][4]; float bv[2];
#pragma unroll
                for (int mm = 0; mm < 2; ++mm) { const int q = wr * 64 + (mp * 2 + mm) * 16 + fr; bv[mm] = bs[head * 128 + q];
#pragma unroll
                    for (int qq = 0; qq < 4; ++qq) { const int col = u.pn * 256 + (qq >> 1) * 128 + wc * 32 + (qq & 1) * 16 + 4 * fq, token = (col >> 7) * 128 + q, d = col & 127;
                        uw[mm][qq] = *(const u32x2*)(ZUV + (size_t)token * 1536 + 512 + head * 128 + d); } }
#pragma unroll
                for (int mm = 0; mm < 2; ++mm) { const int m = mp * 2 + mm, q = wr * 64 + m * 16 + fr; const float b = bv[mm];
#pragma unroll
                    for (int qq = 0; qq < 4; ++qq) { const int col = u.pn * 256 + (qq >> 1) * 128 + wc * 32 + (qq & 1) * 16 + 4 * fq, token = (col >> 7) * 128 + q, d = col & 127;
                        const f32x4 v = acc[ai][qq >> 1][m][qq & 1]; const u32x2 w2 = uw[mm][qq];
                        f32x4 o; o[0] = bflo(w2.x) * (v[0] + b); o[1] = bfhi(w2.x) * (v[1] + b); o[2] = bflo(w2.y) * (v[2] + b); o[3] = bfhi(w2.y) * (v[3] + b);
                        st_bf4(MIX + (size_t)token * 1024 + 512 + head * 128 + d, o); } }
                asm volatile("" ::: "memory");
            }
        }
    }
};

struct RowStat {
    float* slots; unsigned* cnt;
    __device__ __forceinline__ void run(const f32x4 (&v)[2][2][4][2], const Unit& u, int wr, int wc, int fr, int fq, LAS unsigned char* lds, int tid) const {
        LAS float* P = (LAS float*)lds;
        LAS float* S = (LAS float*)(lds + 16384);
#pragma unroll
        for (int ai = 0; ai < 2; ++ai)
#pragma unroll
            for (int m = 0; m < 4; ++m) { float sq = 0.f;
#pragma unroll
                for (int bj = 0; bj < 2; ++bj)
#pragma unroll
                    for (int n = 0; n < 2; ++n) { const f32x4 x = v[ai][bj][m][n]; sq += (x[0] * x[0] + x[1] * x[1]) + (x[2] * x[2] + x[3] * x[3]); }
                P[(ai * 128 + wr * 64 + m * 16 + fr) * 16 + wc * 4 + fq] = sq; }
        asm volatile("s_waitcnt lgkmcnt(0)" ::: "memory"); __builtin_amdgcn_s_barrier(); asm volatile("" ::: "memory");
        if (tid < 256) {
            const LAS f32x4* pr = (const LAS f32x4*)(P + tid * 16); const f32x4 a = pr[0], b = pr[1], c2 = pr[2], d = pr[3];
            const float tot = ((a[0] + a[1]) + (a[2] + a[3])) + ((b[0] + b[1]) + (b[2] + b[3])) + ((c2[0] + c2[1]) + (c2[2] + c2[3])) + ((d[0] + d[1]) + (d[2] + d[3]));
            __hip_atomic_store(slots + ((size_t)(u.pm * 256 + tid) * 4 + u.pn), tot, __ATOMIC_RELAXED, __HIP_MEMORY_SCOPE_AGENT);
            asm volatile("s_waitcnt vmcnt(0)" ::: "memory");
            if ((tid & 63) == 0) __hip_atomic_fetch_add(cnt + 16 * u.pm, 1u, __ATOMIC_RELAXED, __HIP_MEMORY_SCOPE_AGENT);
        }
        if (tid < 64) {
            unsigned sp = 0;
            while ((unsigned)__builtin_amdgcn_readfirstlane(__hip_atomic_load(cnt + 16 * u.pm, __ATOMIC_RELAXED, __HIP_MEMORY_SCOPE_AGENT)) < 16u) { __builtin_amdgcn_s_sleep(1); if (++sp > (1u << 22)) break; }
            __builtin_amdgcn_fence(__ATOMIC_ACQUIRE, "agent");
        }
        asm volatile("s_waitcnt vmcnt(0) lgkmcnt(0)" ::: "memory"); __builtin_amdgcn_s_barrier(); asm volatile("" ::: "memory");
        if (tid < 256) {
            const float* sl = slots + (size_t)(u.pm * 256 + tid) * 4; float tot = 0.f;
#pragma unroll
            for (int t = 0; t < 4; ++t) tot += __hip_atomic_load(sl + t, __ATOMIC_RELAXED, __HIP_MEMORY_SCOPE_AGENT);
            S[tid] = __builtin_amdgcn_rsqf(tot * (1.f / 1024.f) + EPS);
        }
        asm volatile("s_waitcnt vmcnt(0) lgkmcnt(0)" ::: "memory"); __builtin_amdgcn_s_barrier(); asm volatile("" ::: "memory");
    }
};
struct EpiResNorm {
    static constexpr bool AFTER_DRAIN = true;
    float* X; bf16_t* H; const float* bias; const float* mod; int gate_off; const float* g_post; const float* mod_next; int pre_off; const float* g_pre; RowStat st1, st2; int next;
    __device__ __forceinline__ void fused(f32x4 (&acc)[2][2][4][2], const Unit& u, int wr, int wc, int fr, int fq, LAS unsigned char* lds, int tid) const {
        const LAS float* S = (const LAS float*)(lds + 16384);
        const int cond = (u.pm < 32) ? 0 : 1 + ((u.pm - 32) >> 4);
        const int col0 = u.pn * 256 + wc * 32 + 8 * fq;
        if (bias) {
#pragma unroll
            for (int bj = 0; bj < 2; ++bj)
#pragma unroll
                for (int n = 0; n < 2; ++n) { const f32x4 bv = *(const f32x4*)(bias + col0 + bj * 128 + n * 4);
#pragma unroll
                    for (int ai = 0; ai < 2; ++ai)
#pragma unroll
                        for (int m = 0; m < 4; ++m) acc[ai][bj][m][n] += bv; }
        }
        st1.run(acc, u, wr, wc, fr, fq, lds, tid);
        const float* gt = mod + cond * 6144 + gate_off;
        {
            f32x4 gv[4];
#pragma unroll
            for (int q = 0; q < 4; ++q) { const int co = (q >> 1) * 128 + (q & 1) * 4; gv[q] = *(const f32x4*)(gt + col0 + co) * *(const f32x4*)(g_post + col0 + co); }
#pragma unroll
            for (int ai = 0; ai < 2; ++ai)
#pragma unroll
                for (int mp = 0; mp < 2; ++mp) {
                    f32x4 xv[2][4];
#pragma unroll
                    for (int mm = 0; mm < 2; ++mm) { const int r = ai * 128 + wr * 64 + (mp * 2 + mm) * 16 + fr; const float* xp = X + (size_t)(u.pm * 256 + r) * DM + col0;
#pragma unroll
                        for (int q = 0; q < 4; ++q) xv[mm][q] = *(const f32x4*)(xp + (q >> 1) * 128 + (q & 1) * 4); }
#pragma unroll
                    for (int mm = 0; mm < 2; ++mm) { const int m = mp * 2 + mm, r = ai * 128 + wr * 64 + m * 16 + fr; const float r1 = S[r]; float* xp = X + (size_t)(u.pm * 256 + r) * DM + col0;
#pragma unroll
                        for (int q = 0; q < 4; ++q) { const f32x4 xn = xv[mm][q] + gv[q] * (acc[ai][q >> 1][m][q & 1] * r1); *(f32x4*)(xp + (q >> 1) * 128 + (q & 1) * 4) = xn; acc[ai][q >> 1][m][q & 1] = xn; } }
                    asm volatile("" ::: "memory"); }
        }
        if (next) {
            st2.run(acc, u, wr, wc, fr, fq, lds, tid);
            const float* sh = mod_next + cond * 6144 + pre_off; const float* sc = sh + 1024;
            f32x4 av[4], s0[4];
#pragma unroll
            for (int q = 0; q < 4; ++q) { const int co = (q >> 1) * 128 + (q & 1) * 4; av[q] = *(const f32x4*)(g_pre + col0 + co) * (1.f + *(const f32x4*)(sc + col0 + co)); s0[q] = *(const f32x4*)(sh + col0 + co); }
#pragma unroll
            for (int ai = 0; ai < 2; ++ai)
#pragma unroll
                for (int m = 0; m < 4; ++m) { const int r = ai * 128 + wr * 64 + m * 16 + fr; const float r2 = S[r]; bf16_t* hp = H + (size_t)(u.pm * 256 + r) * DM + col0;
#pragma unroll
                    for (int bj = 0; bj < 2; ++bj) { const f32x4 h0 = acc[ai][bj][m][0] * r2 * av[2 * bj] + s0[2 * bj], h1 = acc[ai][bj][m][1] * r2 * av[2 * bj + 1] + s0[2 * bj + 1];
                        u32x4 w; w.x = pk2(h0[0], h0[1]); w.y = pk2(h0[2], h0[3]); w.z = pk2(h1[0], h1[1]); w.w = pk2(h1[2], h1[3]); *(u32x4*)(hp + bj * 128) = w; } }
        }
    }
};

template <class J, class Epi>
__device__ __forceinline__ void gemm_phase(LAS unsigned char* lds, const J g, int ubase, int c, int G, const Epi& E, int wv) {
    const int tid = tid_fresh(wv), wid = __builtin_amdgcn_readfirstlane(tid >> 6), lane = tid & 63, wr = wid >> 2, wc = wid & 3, fr = lane & 15, fq = lane >> 4;
    const int K = g.K, nt = K / BK;
    int u0; { int i0 = (ubase > c) ? (ubase - c + G - 1) / G : 0; u0 = c + i0 * G - ubase; }
    Unit cur, nxt; int ui = 0;
    if (!unit_at(g, u0, cur)) return;
    unsigned voffA[2], voffB[2];
#pragma unroll
    for (int i = 0; i < 2; ++i) { int R, C; stage_rc(tid * 16 + i * 8192, R, C); const int Rb = EpiPerm<Epi>::v ? ((R & ~31) + perm32(R & 31)) : R; voffA[i] = (unsigned)(R * g.lda + C) * 2u; voffB[i] = (unsigned)(Rb * g.ldb + C) * 2u; }
    const size_t kstep = (size_t)(BK * 2);
    const size_t hstepA = (size_t)HALF * g.lda * 2, hstepB = (size_t)HALF * g.ldb * 2;
    const unsigned ldsw = (unsigned)wid * 1024u;
    const int aoff = lds_byte(wr * 64 + fr, fq * 8), boff = lds_byte(wc * 32 + fr, fq * 8);
#define PG8_SA(b, h) (((b) * 2 + (h)) * HTB)
#define PG8_SB(b, h) ((4 + (b) * 2 + (h)) * HTB)
#define PG8_STAGE(bufoff, gbase, voff) do { _Pragma("unroll") for (int _i = 0; _i < 2; ++_i) \
        __builtin_amdgcn_global_load_lds((const unsigned*)((const char*)(gbase) + (voff)[_i]), (LAS unsigned*)(lds + (bufoff) + ldsw + _i * 8192), 16, 0, 0); } while (0)
#define PG8_LDA(dst, b, h) do { _Pragma("unroll") for (int m = 0; m < 4; ++m) _Pragma("unroll") for (int k = 0; k < 2; ++k) dst[m][k] = *(const LAS bf16x8*)(lds + PG8_SA(b, h) + aoff + m * 2048 + k * 1024); } while (0)
#define PG8_LDB(dst, b, h) do { _Pragma("unroll") for (int n = 0; n < 2; ++n) _Pragma("unroll") for (int k = 0; k < 2; ++k) dst[n][k] = *(const LAS bf16x8*)(lds + PG8_SB(b, h) + boff + n * 2048 + k * 1024); } while (0)
#define PG8_MMA(ai, bj, At, Bt) do { __builtin_amdgcn_s_setprio(1); _Pragma("unroll") for (int m = 0; m < 4; ++m) _Pragma("unroll") for (int n = 0; n < 2; ++n) _Pragma("unroll") for (int k = 0; k < 2; ++k) \
        acc[ai][bj][m][n] = __builtin_amdgcn_mfma_f32_16x16x32_bf16(Bt[n][k], At[m][k], acc[ai][bj][m][n], 0, 0, 0); __builtin_amdgcn_s_setprio(0); } while (0)
#define PG8_WAIT_V(n) asm volatile("s_waitcnt vmcnt(" #n ")" ::: "memory")
#define PG8_WAIT_L(n) asm volatile("s_waitcnt lgkmcnt(" #n ")" ::: "memory")
#define PG8_BAR __builtin_amdgcn_s_barrier()
#define PG8_SCHED __builtin_amdgcn_sched_barrier(0)
    f32x4 acc[2][2][4][2];
#pragma unroll
    for (int a = 0; a < 2; ++a)
#pragma unroll
        for (int b = 0; b < 2; ++b)
#pragma unroll
            for (int m = 0; m < 4; ++m)
#pragma unroll
                for (int n = 0; n < 2; ++n) acc[a][b][m][n] = (f32x4){0.f, 0.f, 0.f, 0.f};
    bf16x8 At[4][2], B0[2][2], B1[2][2];
    const char* cA = (const char*)(g.A + (size_t)cur.b * g.sA) + (size_t)cur.pm * 2 * hstepA;
    const char* cB = (const char*)(g.B + (size_t)cur.b * g.sB) + (size_t)cur.pn * 2 * hstepB;
    PG8_STAGE(PG8_SB(0, 0), cB, voffB); PG8_STAGE(PG8_SA(0, 0), cA, voffA); PG8_STAGE(PG8_SB(0, 1), cB + hstepB, voffB); PG8_STAGE(PG8_SA(0, 1), cA + hstepA, voffA);
    if (wr == 1) PG8_BAR;
    PG8_WAIT_V(4); PG8_BAR;
    PG8_STAGE(PG8_SB(1, 0), cB + kstep, voffB); PG8_STAGE(PG8_SA(1, 0), cA + kstep, voffA); PG8_STAGE(PG8_SB(1, 1), cB + hstepB + kstep, voffB);
    PG8_WAIT_V(6); PG8_BAR;
    for (;;) {
        const bool has_next = unit_at(g, u0 + (ui + 1) * G, nxt);
        const char* nA = has_next ? (const char*)(g.A + (size_t)nxt.b * g.sA) + (size_t)nxt.pm * 2 * hstepA : cA;
        const char* nB = has_next ? (const char*)(g.B + (size_t)nxt.b * g.sB) + (size_t)nxt.pn * 2 * hstepB : cB;
        for (int t = 0; t < nt; t += 2) {
            const bool last = (t == nt - 2);
            const char* a1 = cA + (size_t)(t + 1) * kstep;
            const char* a2 = last ? nA : cA + (size_t)(t + 2) * kstep; const char* b2 = last ? nB : cB + (size_t)(t + 2) * kstep;
            const char* a3 = a2 + kstep; const char* b3 = b2 + kstep;
            PG8_LDB(B0, 0, 0); PG8_SCHED; PG8_LDA(At, 0, 0); PG8_STAGE(PG8_SA(1, 1), a1 + hstepA, voffA);
            PG8_WAIT_L(8); PG8_BAR; PG8_WAIT_L(0); PG8_MMA(0, 0, At, B0); PG8_BAR; PG8_SCHED;
            PG8_LDB(B1, 0, 1); PG8_STAGE(PG8_SB(0, 0), b2, voffB);
            PG8_BAR; PG8_WAIT_L(0); PG8_MMA(0, 1, At, B1); PG8_BAR;
            PG8_LDA(At, 0, 1); PG8_STAGE(PG8_SA(0, 0), a2, voffA);
            PG8_BAR; PG8_WAIT_L(0); PG8_MMA(1, 0, At, B0); PG8_BAR; PG8_SCHED;
            PG8_STAGE(PG8_SB(0, 1), b2 + hstepB, voffB);
            PG8_WAIT_V(6); PG8_BAR; PG8_MMA(1, 1, At, B1); PG8_BAR;
            PG8_LDB(B0, 1, 0); PG8_SCHED; PG8_LDA(At, 1, 0); PG8_STAGE(PG8_SA(0, 1), a2 + hstepA, voffA);
            PG8_WAIT_L(8); PG8_BAR; PG8_WAIT_L(0); PG8_MMA(0, 0, At, B0); PG8_BAR; PG8_SCHED;
            PG8_LDB(B1, 1, 1); PG8_STAGE(PG8_SB(1, 0), b3, voffB);
            PG8_BAR; PG8_WAIT_L(0); PG8_MMA(0, 1, At, B1); PG8_BAR;
            PG8_LDA(At, 1, 1); PG8_STAGE(PG8_SA(1, 0), a3, voffA);
            PG8_BAR; PG8_WAIT_L(0); PG8_MMA(1, 0, At, B0); PG8_BAR; PG8_SCHED;
            PG8_STAGE(PG8_SB(1, 1), b3 + hstepB, voffB);
            PG8_WAIT_V(6); PG8_BAR; PG8_MMA(1, 1, At, B1); PG8_BAR;
        }
        if constexpr (!Epi::AFTER_DRAIN) E(acc, cur, wr, wc, fr, fq);
        if (!has_next) break;
#pragma unroll
        for (int a = 0; a < 2; ++a)
#pragma unroll
            for (int b = 0; b < 2; ++b)
#pragma unroll
                for (int m = 0; m < 4; ++m)
#pragma unroll
                    for (int n = 0; n < 2; ++n) acc[a][b][m][n] = (f32x4){0.f, 0.f, 0.f, 0.f};
        cur = nxt; cA = nA; cB = nB; ++ui;
    }
    PG8_WAIT_V(0);
    if (wr == 0) PG8_BAR;
    PG8_BAR;
    if constexpr (Epi::AFTER_DRAIN) E.fused(acc, cur, wr, wc, fr, fq, lds, tid);
#undef PG8_SA
#undef PG8_SB
#undef PG8_STAGE
#undef PG8_LDA
#undef PG8_LDB
#undef PG8_MMA
#undef PG8_WAIT_V
#undef PG8_WAIT_L
#undef PG8_BAR
#undef PG8_SCHED
}

__device__ __forceinline__ void transpose_item(const float* W, int ldw, int Nsrc, bf16_t* WT, int ldt, int koff, LAS float* scrf, int item, int lane) {
    LAS unsigned* scr = (LAS unsigned*)scrf;
    const int nblk = Nsrc / 64, kb = item / nblk, nb = item % nblk, k0 = 64 * kb, n0 = 64 * nb, r = lane >> 4, cq = (lane & 15) * 4;
    { const float* src = W + (size_t)(k0 + r) * ldw + n0 + cq; f32x4 v[16];
#pragma unroll
      for (int i = 0; i < 16; ++i) v[i] = *(const f32x4*)(src + (size_t)(4 * i) * ldw);
#pragma unroll
      for (int i = 0; i < 16; ++i) { const int k = 4 * i + r; LAS unsigned* d2 = scr + k * 33 + (cq >> 1); d2[0] = pk2(v[i][0], v[i][1]); d2[1] = pk2(v[i][2], v[i][3]); } }
    LDS_WAIT();
    const int c8 = lane & 7, np = lane >> 3;
#pragma unroll
    for (int j = 0; j < 4; ++j) { const int n2 = j * 8 + np;
        unsigned w[8];
#pragma unroll
        for (int e = 0; e < 8; ++e) w[e] = scr[(c8 * 8 + e) * 33 + n2];
        u32x4 lo, hi;
        lo.x = (w[0] & 0xffffu) | (w[1] << 16); lo.y = (w[2] & 0xffffu) | (w[3] << 16); lo.z = (w[4] & 0xffffu) | (w[5] << 16); lo.w = (w[6] & 0xffffu) | (w[7] << 16);
        hi.x = (w[0] >> 16) | (w[1] & 0xffff0000u); hi.y = (w[2] >> 16) | (w[3] & 0xffff0000u); hi.z = (w[4] >> 16) | (w[5] & 0xffff0000u); hi.w = (w[6] >> 16) | (w[7] & 0xffff0000u);
        bf16_t* dst = WT + (size_t)(n0 + 2 * n2) * ldt + koff + k0 + 8 * c8;
        *(u32x4*)dst = lo; *(u32x4*)(dst + ldt) = hi; }
    LDS_WAIT();
}

template <int D>
__device__ __forceinline__ void fold_item(const float* coef, const float* scale, const float* W, int ldw, bf16_t* dst, LAS float* scr, int lane) {
    float acc[16];
#pragma unroll
    for (int i = 0; i < 16; ++i) acc[i] = 0.f;
#pragma unroll 1
    for (int dc = 0; dc < D; dc += 64) {
        float cr[16]; const float sc = scale ? scale[dc + lane] : 1.f;
#pragma unroll
        for (int i = 0; i < 16; ++i) cr[i] = coef[(size_t)i * D + dc + lane];
        { float v[64];
#pragma unroll
          for (int d = 0; d < 64; ++d) v[d] = W[(size_t)(dc + d) * ldw + lane];
#pragma unroll
          for (int d = 0; d < 64; ++d) scr[d * 64 + lane] = v[d]; }
#pragma unroll
        for (int i = 0; i < 16; ++i) cr[i] *= sc;
        LDS_WAIT();
#pragma unroll 8
        for (int d = 0; d < 64; ++d) { const float w = scr[d * 64 + lane];
#pragma unroll
            for (int i = 0; i < 16; ++i) acc[i] += __int_as_float(__builtin_amdgcn_readlane(__float_as_int(cr[i]), d)) * w; }
        LDS_WAIT();
    }
    u32x4 o0, o1; o0.x = pk2(acc[0], acc[1]); o0.y = pk2(acc[2], acc[3]); o0.z = pk2(acc[4], acc[5]); o0.w = pk2(acc[6], acc[7]);
    o1.x = pk2(acc[8], acc[9]); o1.y = pk2(acc[10], acc[11]); o1.z = pk2(acc[12], acc[13]); o1.w = pk2(acc[14], acc[15]);
    *(u32x4*)dst = o0; *(u32x4*)(dst + 8) = o1;
}

__device__ __forceinline__ void row_pass0(const Params& p, float* X, bf16_t* HY, const float* mod_next, const float* g_pre, int gw, int nw, int lane) {
    for (int row0 = gw; row0 < NTOK; row0 += 4 * nw) {
        f32x4 x[4][4];
#pragma unroll
        for (int r = 0; r < 4; ++r) { const int row = row0 + r * nw; if (row >= NTOK) continue;
            const float* src = (row < NPR) ? (p.in[0] + (size_t)row * DM + 4 * lane) : (p.in[1] + (size_t)(row - NPR) * DM + 4 * lane);
#pragma unroll
            for (int j = 0; j < 4; ++j) x[r][j] = *(const f32x4*)(src + 256 * j); }
#pragma unroll
        for (int r = 0; r < 4; ++r) { const int row = row0 + r * nw; if (row >= NTOK) continue;
            const int cond = row < NPR ? 0 : 1 + ((row - NPR) >> 12);
            float* xr = X + (size_t)row * DM + 4 * lane;
            if (row >= NPR) { const int t = (row - NPR) & 4095; const float pr = (float)(t >> 6), pc = (float)(t & 63);
#pragma unroll
                for (int j = 0; j < 4; ++j)
#pragma unroll
                    for (int e = 0; e < 4; ++e) { const int i = 4 * lane + e; const float om = __builtin_amdgcn_exp2f(-(float)i * (13.287712379549449f / 256.f));
                        const float ang = ((j < 2) ? pr : pc) * om; float sn, cn; sincos_rev(ang * 0.15915494309189535f, sn, cn); x[r][j][e] += (j & 1) ? cn : sn; } }
            float ss = 0.f;
#pragma unroll
            for (int j = 0; j < 4; ++j) { *(f32x4*)(xr + 256 * j) = x[r][j]; ss += (x[r][j][0] * x[r][j][0] + x[r][j][1] * x[r][j][1]) + (x[r][j][2] * x[r][j][2] + x[r][j][3] * x[r][j][3]); }
            const float rstd = __builtin_amdgcn_rsqf(wave_sum(ss) * (1.f / DM) + EPS);
            const float* sh = mod_next + cond * 6144 + 4 * lane; const float* sc = sh + 1024;
            bf16_t* hr = HY + (size_t)row * DM + 4 * lane;
#pragma unroll
            for (int j = 0; j < 4; ++j) { const f32x4 gp = *(const f32x4*)(g_pre + 4 * lane + 256 * j); const f32x4 s1 = *(const f32x4*)(sc + 256 * j); const f32x4 s0 = *(const f32x4*)(sh + 256 * j);
                st_bf4(hr + 256 * j, x[r][j] * rstd * gp * (1.f + s1) + s0); }
        }
    }
}

constexpr int CI0 = 16 * 16  , CI1 = CI0 + 12 * 12  , CI2 = CI1 + 12 * 16  , CI3 = CI2 + 16 * 24  , CI4 = CI3 + 16 * 64  ,
              CI5 = CI4 + 64 * 16  , CI6 = CI5 + 8 * 16  ;
#define CONV_ITEMS(LO, HI, WIDX, NWV) do { for (int it_ = (LO) + (WIDX); it_ < (HI); it_ += (NWV)) { \
        if (it_ < CI0) transpose_item(p.in[14], 1024, 1024, WIN0, 1024, 0, scr, it_, lane); \
        else if (it_ < CI1) transpose_item(p.in[24], 768, 768, WGLU, 768, 0, scr, it_ - CI0, lane); \
        else if (it_ < CI2) transpose_item(p.in[15], 1024, 1024, WOUT0, 1280, 0, scr, it_ - CI1, lane); \
        else if (it_ < CI3) transpose_item(p.in[36], 1536, 1536, WIN1, 1024, 0, scr, it_ - CI2, lane); \
        else if (it_ < CI4) transpose_item(p.in[12], 4096, 4096, WFF1, 1024, 0, scr, it_ - CI3, lane); \
        else if (it_ < CI5) transpose_item(p.in[13], 1024, 1024, WFF2, 4096, 0, scr, it_ - CI4, lane); \
        else transpose_item(p.in[37] + (size_t)512 * 1024, 1024, 1024, WOUT1, 1024, 512, scr, it_ - CI5, lane); } } while (0)
#define FOLD_ITEMS(LO, HI, WIDX, NWV) do { for (int it_ = (LO) + (WIDX); it_ < (HI); it_ += (NWV)) { \
        if (it_ < 16) { const int n = it_ * 64 + lane; float sm = 0.f; \
            _Pragma("unroll 1") for (int jc = 0; jc < 256; jc += 64) { const float fb = p.in[27][jc + lane]; float v[64]; \
                _Pragma("unroll") for (int j = 0; j < 64; ++j) v[j] = p.in[15][(size_t)(768 + jc + j) * 1024 + n]; \
                _Pragma("unroll") for (int j = 0; j < 64; ++j) sm += __int_as_float(__builtin_amdgcn_readlane(__float_as_int(fb), j)) * v[j]; } \
            BIAS0[n] = sm; } \
        else { const int it = it_ - 16; const int nb = it & 15, cb = (it >> 4) & 7, g = it >> 7, n = nb * 64 + lane; \
            fold_item<128>(p.in[38] + (size_t)(g * 128 + cb * 16) * 128, p.in[39] + g * 128, p.in[37] + (size_t)(g * 128) * 1024 + nb * 64, 1024, WOUT1 + (size_t)n * 1024 + g * 128 + cb * 16, scr, lane); } } } while (0)

__global__ void __launch_bounds__(512, 2) mega_fwd(Params p) {
    extern __shared__ __attribute__((aligned(16))) unsigned char smem[];
    LAS unsigned char* lds = (LAS unsigned char*)smem;
    cg::grid_group grid = cg::this_grid();
    const int wv = __builtin_amdgcn_readfirstlane((int)(threadIdx.x >> 6));
    volatile LAS unsigned* xb_st = (volatile LAS unsigned*)(lds + 131072);
    unsigned* xb_bar = (unsigned*)(p.ws + WS_BAR);
    if (threadIdx.x == 0) { xb_st[0] = 0u; xb_st[1] = 0u; (void)xb_add(&xb_bar[XB_XCNT(xb_xcc_id())], 1u); }
    __syncthreads();
    if (p.ws == nullptr) grid.sync();
#define GSYNC() xcd_barrier((unsigned*)(p.ws + WS_BAR), (volatile LAS unsigned*)(lds + 131072), wv)
    const int G = gridDim.x, c = blockIdx.x, GT = G * 512, NW = G * 8;
#define PHASE_PTRS unsigned long long wz_ = 0; asm volatile("" : "+s"(wz_)); unsigned char* ws = p.ws + wz_; \
    float* X = p.out; \
    bf16_t* WFF1 = (bf16_t*)(ws + WS_WFF1); bf16_t* WFF2 = (bf16_t*)(ws + WS_WFF2); bf16_t* WIN0 = (bf16_t*)(ws + WS_WIN0); bf16_t* WGLU = (bf16_t*)(ws + WS_WGLU); \
    bf16_t* WOUT0 = (bf16_t*)(ws + WS_WOUT0); bf16_t* WIN1 = (bf16_t*)(ws + WS_WIN1); bf16_t* WOUT1 = (bf16_t*)(ws + WS_WOUT1); \
    bf16_t* ME = (bf16_t*)(ws + WS_ME); bf16_t* SG = (bf16_t*)(ws + WS_SG); bf16_t* D512 = (bf16_t*)(ws + WS_D512); bf16_t* A2 = (bf16_t*)(ws + WS_A2); \
    float* MOD = (float*)(ws + WS_MOD); f32x2* APOW = (f32x2*)(ws + WS_APOW); f32x2* BBT = (f32x2*)(ws + WS_BBT); float* KTAB = (float*)(ws + WS_KTAB); \
    float* CSW = (float*)(ws + WS_CSW); float* BIAS0 = (float*)(ws + WS_BIAS0); \
    bf16_t* HY = (bf16_t*)(ws + WS_HY); bf16_t* MIX = (bf16_t*)(ws + WS_MIX); \
    bf16_t* UH = (bf16_t*)(ws + WS_UH); float* SLOC = (float*)(ws + WS_SLOC); bf16_t* GB = (bf16_t*)(ws + WS_G); \
    bf16_t* ZT = (bf16_t*)(ws + WS_ZT); bf16_t* YT = (bf16_t*)(ws + WS_YT); bf16_t* ZUV = (bf16_t*)(ws + WS_ZUV); bf16_t* VT = (bf16_t*)(ws + WS_VT); \
    bf16_t* HMID = (bf16_t*)(ws + WS_HMID);
#define PHASE_IDS PHASE_PTRS const int tid = tid_fresh(wv), lane = tid & 63, wave = __builtin_amdgcn_readfirstlane(tid >> 6), gtid = c * 512 + tid, gw = wave * G + c; \
    LAS float* scr = (LAS float*)(lds + wave * 16384); (void)lane; (void)gtid; (void)gw; (void)scr;
#pragma unroll 1
    for (int rep = 0; rep < REP_P0; ++rep) {
        PHASE_IDS
        for (int cgi = c; cgi < 192; cgi += G) {
            const int layer = cgi / 96, r96 = cgi % 96, strip = r96 % 12, ks = r96 / 12;
            LAS float* sl = (LAS float*)lds; LAS float* red = sl + 3072;
            for (int i = tid; i < 3072; i += 512) { const int cd = i >> 10, k = i & 1023; const float v = (cd == 0) ? PIN(5)[k] : PIN(4)[(cd - 1) * 1024 + k]; sl[i] = v * sigm(v); }
            __syncthreads();
            const float* Wm = PIN(layer ? 28 : 6) + (size_t)(ks * 128 + wave * 16) * 6144 + strip * 512 + lane * 4;
            f32x4 a0 = {0.f, 0.f, 0.f, 0.f}, a1 = a0, a2 = a0, b0 = a0, b1 = a0, b2 = a0;
#pragma unroll
            for (int i = 0; i < 16; ++i) { const int k = ks * 128 + wave * 16 + i; const f32x4 w0 = *(const f32x4*)(Wm + (size_t)i * 6144), w1 = *(const f32x4*)(Wm + (size_t)i * 6144 + 256);
                const float s0 = sl[k], s1 = sl[1024 + k], s2 = sl[2048 + k]; a0 += s0 * w0; a1 += s1 * w0; a2 += s2 * w0; b0 += s0 * w1; b1 += s1 * w1; b2 += s2 * w1; }
            { LAS float* r = red + wave * 1536 + lane * 4; *(LAS f32x4*)r = a0; *(LAS f32x4*)(r + 256) = b0; *(LAS f32x4*)(r + 512) = a1; *(LAS f32x4*)(r + 768) = b1; *(LAS f32x4*)(r + 1024) = a2; *(LAS f32x4*)(r + 1280) = b2; }
            __syncthreads();
            for (int o = tid; o < 1536; o += 512) { const int cd = o >> 9, col = o & 511; float sm = (ks == 0) ? PIN(layer ? 29 : 7)[strip * 512 + col] : 0.f;
#pragma unroll
                for (int w = 0; w < 8; ++w) sm += red[w * 1536 + o];
                atomicAdd(MOD + (layer * 3 + cd) * 6144 + strip * 512 + col, sm); }
            __syncthreads();
        }
        const int hb = c - 204, nhb = G - 204;
        if (hb >= 0) CONV_ITEMS(0, CI1, hb * 8 + wave, nhb * 8);
        if (hb >= 0) for (int idx = hb * 512 + tid; idx < 32768; idx += nhb * 512) {
            const int d = idx & 63, cc = (idx >> 6) & 63, cs = (idx >> 12) & 1, g = idx >> 13; float sm = 0.f;
            const float* fw = PIN(26) + (size_t)(g * 64) * 64 + d;
#pragma unroll
            for (int m0 = 0; m0 < 64; m0 += 16) { float w[16];
#pragma unroll
                for (int k = 0; k < 16; ++k) w[k] = fw[(m0 + k) * 64];
#pragma unroll
                for (int k = 0; k < 16; ++k) { float sn, cn; sincos_rev((float)(((m0 + k) * cc) & 63) * (1.f / 64.f), sn, cn); sm += (cs ? sn : cn) * w[k]; } }
            CSW[idx] = sm;
        }
        for (int idx = gtid; idx < 131072; idx += GT) {
            const int kk = idx & 127, hp = (idx >> 7) & 1, q = (idx >> 8) & 127, h = (idx >> 15) & 1, pair = idx >> 16;
            A2[idx] = (h == hp) ? f2bf(PIN(42)[((pair * 2 + h) * 128 + q) * 128 + kk]) : (bf16_t)0;
        }
        for (int idx = gtid; idx < 262144; idx += GT) {
            const int l2 = idx & 255, csp = (idx >> 8) & 1, k2 = (idx >> 9) & 255, cs = idx >> 17; float sn, cn; sincos_rev((float)((k2 * l2) & 255) * (1.f / 256.f), sn, cn);
            D512[idx] = f2bf(cs == csp ? cn : (cs ? -sn : sn));
        }
        if (c >= 192) for (int idx = (c - 192) * 512 + tid; idx < 6144 * 33; idx += (G - 192) * 512) {
            const int e = idx / 6144, q = idx - e * 6144, pp = q & 63, dir = (q >> 6) & 1, g = q >> 7; const int li = (dir * 48 + g) * 64 + pp;
            const float lr = PIN(16)[li], lim = PIN(17)[li], dt = fexp(PIN(18)[dir * 48 + g]);
            if (e < 17) { const float mag = fexp(lr * dt * (float)e); float sn, cn; sincos_rev(lim * dt * (float)e * 0.15915494309189535f, sn, cn); APOW[((g * 2 + dir) * 17 + e) * 64 + pp] = (f32x2){mag * cn, mag * sn}; }
            else { const int h = e - 17; const float mag = fexp(lr * dt); float sn, cn; sincos_rev(lim * dt * 0.15915494309189535f, sn, cn);
                const float nr = mag * cn - 1.f, ni = mag * sn, den = lr * lr + lim * lim;
                const float cr = (nr * lr + ni * lim) / den, ci = (ni * lr - nr * lim) / den;
                const float br = PIN(19)[(size_t)li * 16 + h], bi = PIN(20)[(size_t)li * 16 + h]; BBT[((g * 2 + dir) * 64 + pp) * 16 + h] = (f32x2){cr * br - ci * bi, cr * bi + ci * br}; }
        }
        if (rep + 1 < REP_P0) GSYNC();
    }
    GSYNC();
#pragma unroll 1
    for (int es = 0; es < EXTRA_SYNC; ++es) GSYNC();

#pragma unroll 1
    for (int rep = 0; rep < REP_P1; ++rep) {
        PHASE_IDS
        row_pass0(p, X, HY, MOD, PIN(8), gw, NW, lane);
        if (c >= 192) FOLD_ITEMS(0, 16, (G - 192) * 8 - 1 - ((c - 192) * 8 + wave), (G - 192) * 8);
        if (c >= 192) for (int it = (c - 192) * 8 + wave; it < 512; it += (G - 192) * 8) {
            const int nb = it & 15, jb = it >> 4, g = jb >> 3, n = nb * 64 + lane;
            fold_item<64>(CSW + (size_t)(jb * 16) * 64, nullptr, PIN(15) + (size_t)(768 + g * 64) * 1024 + nb * 64, 1024, WOUT0 + (size_t)n * 1280 + 768 + jb * 16, scr, lane);
        }
        for (int idx = gtid; idx < 98304; idx += GT) {
            const int hq = idx & 3, h = (idx >> 2) & 15, j = (idx >> 6) & 15, dir = (idx >> 10) & 1, g = idx >> 11; f32x4 sm = {0.f, 0.f, 0.f, 0.f};
            const float* cre = PIN(21) + ((size_t)(dir * 48 + g) * 16 + h) * 64; const float* cim = PIN(22) + ((size_t)(dir * 48 + g) * 16 + h) * 64;
            const f32x2* ap = APOW + ((g * 2 + dir) * 17 + j) * 64; const f32x4* bb = (const f32x4*)(BBT + (size_t)((g * 2 + dir) * 64) * 16 + hq * 4);
#pragma unroll 8
            for (int pp = 0; pp < 64; ++pp) { const f32x2 a = ap[pp]; const float cr = cre[pp], ci = cim[pp]; const float er = cr * a.x - ci * a.y, ei = cr * a.y + ci * a.x;
                const f32x4 b0 = bb[pp * 8], b1 = bb[pp * 8 + 1];
                sm[0] += er * b0[0] - ei * b0[1]; sm[1] += er * b0[2] - ei * b0[3]; sm[2] += er * b1[0] - ei * b1[1]; sm[3] += er * b1[2] - ei * b1[3]; }
            *(f32x4*)(KTAB + (size_t)idx * 4) = sm;
        }
#pragma unroll 3
        for (int idx = gtid; idx < 48 * 8192; idx += GT) {
            const int p8 = (idx & 7) * 8, ri = (idx >> 3) & 1, dir = (idx >> 4) & 1, h = (idx >> 5) & 15, tau = (idx >> 9) & 15, g = idx >> 13;
            const int e = dir ? (16 - tau) : (tau + 1); const f32x4* ap = (const f32x4*)(APOW + ((g * 2 + dir) * 17 + e) * 64 + p8);
            const size_t ci = ((size_t)(dir * 48 + g) * 16 + h) * 64 + p8; const f32x4* crp = (const f32x4*)(PIN(21) + ci); const f32x4* cip = (const f32x4*)(PIN(22) + ci);
            const f32x4 a0 = ap[0], a1 = ap[1], a2 = ap[2], a3 = ap[3], cr0 = crp[0], cr1 = crp[1], ci0 = cip[0], ci1 = cip[1];
            float o[8];
            if (ri) { o[0] = -(cr0[0] * a0[1] + ci0[0] * a0[0]); o[1] = -(cr0[1] * a0[3] + ci0[1] * a0[2]); o[2] = -(cr0[2] * a1[1] + ci0[2] * a1[0]); o[3] = -(cr0[3] * a1[3] + ci0[3] * a1[2]);
                      o[4] = -(cr1[0] * a2[1] + ci1[0] * a2[0]); o[5] = -(cr1[1] * a2[3] + ci1[1] * a2[2]); o[6] = -(cr1[2] * a3[1] + ci1[2] * a3[0]); o[7] = -(cr1[3] * a3[3] + ci1[3] * a3[2]); }
            else    { o[0] = cr0[0] * a0[0] - ci0[0] * a0[1]; o[1] = cr0[1] * a0[2] - ci0[1] * a0[3]; o[2] = cr0[2] * a1[0] - ci0[2] * a1[1]; o[3] = cr0[3] * a1[2] - ci0[3] * a1[3];
                      o[4] = cr1[0] * a2[0] - ci1[0] * a2[1]; o[5] = cr1[1] * a2[2] - ci1[1] * a2[3]; o[6] = cr1[2] * a3[0] - ci1[2] * a3[1]; o[7] = cr1[3] * a3[2] - ci1[3] * a3[3]; }
            u32x4 w; w.x = pk2(o[0], o[1]); w.y = pk2(o[2], o[3]); w.z = pk2(o[4], o[5]); w.w = pk2(o[6], o[7]);
            *(u32x4*)(ME + ((size_t)g * 256 + tau * 16 + h) * 512 + 256 + dir * 128 + ri * 64 + p8) = w;
        }
#pragma unroll 3
        for (int idx = gtid; idx < 48 * 8192; idx += GT) {
            const int h8 = (idx & 1) * 8, sq = (idx >> 1) & 15, pp = (idx >> 5) & 63, ri = (idx >> 11) & 1, dir = (idx >> 12) & 1, g = idx >> 13;
            const int e = dir ? sq : (15 - sq); const f32x2 a = APOW[((g * 2 + dir) * 17 + e) * 64 + pp]; const f32x4* bp = (const f32x4*)(BBT + ((g * 2 + dir) * 64 + pp) * 16 + h8);
            const f32x4 b0 = bp[0], b1 = bp[1], b2 = bp[2], b3 = bp[3];
            float o[8];
            if (ri) { o[0] = a.x * b0[1] + a.y * b0[0]; o[1] = a.x * b0[3] + a.y * b0[2]; o[2] = a.x * b1[1] + a.y * b1[0]; o[3] = a.x * b1[3] + a.y * b1[2];
                      o[4] = a.x * b2[1] + a.y * b2[0]; o[5] = a.x * b2[3] + a.y * b2[2]; o[6] = a.x * b3[1] + a.y * b3[0]; o[7] = a.x * b3[3] + a.y * b3[2]; }
            else    { o[0] = a.x * b0[0] - a.y * b0[1]; o[1] = a.x * b0[2] - a.y * b0[3]; o[2] = a.x * b1[0] - a.y * b1[1]; o[3] = a.x * b1[2] - a.y * b1[3];
                      o[4] = a.x * b2[0] - a.y * b2[1]; o[5] = a.x * b2[2] - a.y * b2[3]; o[6] = a.x * b3[0] - a.y * b3[1]; o[7] = a.x * b3[2] - a.y * b3[3]; }
            u32x4 w; w.x = pk2(o[0], o[1]); w.y = pk2(o[2], o[3]); w.z = pk2(o[4], o[5]); w.w = pk2(o[6], o[7]);
            *(u32x4*)(SG + (size_t)idx * 8) = w;
        }
        if (rep + 1 < REP_P1) GSYNC();
    }
    GSYNC();

    {
        PHASE_IDS
#pragma unroll 3
        for (int idx = gtid; idx < 48 * 8192; idx += GT) {
            const int h8 = (idx & 1) * 8, sq = (idx >> 1) & 15, h = (idx >> 5) & 15, tau = (idx >> 9) & 15, g = idx >> 13;
            f32x4 v0 = {0.f, 0.f, 0.f, 0.f}, v1 = v0;
            if (sq <= tau) { const f32x4* k = (const f32x4*)(KTAB + (((g * 2 + 0) * 16 + (tau - sq)) * 16 + h) * 16 + h8); v0 += k[0]; v1 += k[1]; }
            if (sq >= tau) { const f32x4* k = (const f32x4*)(KTAB + (((g * 2 + 1) * 16 + (sq - tau)) * 16 + h) * 16 + h8); v0 += k[0]; v1 += k[1]; }
            if (sq == tau && (h >> 3) == (h8 >> 3)) { const float dv = p.in[23][g * 16 + h]; const int hl = h & 7;
                if (hl < 4) v0[hl] += dv; else v1[hl - 4] += dv; }
            u32x4 w; w.x = pk2(v0[0], v0[1]); w.y = pk2(v0[2], v0[3]); w.z = pk2(v1[0], v1[1]); w.w = pk2(v1[2], v1[3]);
            *(u32x4*)(ME + ((size_t)g * 256 + tau * 16 + h) * 512 + sq * 16 + h8) = w;
        }
    }
    {
        PHASE_IDS
        GJob<1024, 1024, 1024, 64, 3, 1, 0, 0> ja{HY, WIN0};
        gemm_phase(lds, ja, 0, c, G, EpiU{UH}, wv);
        GJob<1024, 1024, 1024, 1, 64, 1, 0, 0> jb{WIN0 + (size_t)768 * 1024, HY};
        gemm_phase(lds, jb, 192, c, G, EpiZt{ZT}, wv);
    }
    GSYNC();

    {
        PHASE_IDS
        for (int idx = gtid; idx < 131072; idx += GT) {
            const int l2 = idx & 255, ch = (idx >> 8) & 255, b = idx >> 16;
            const bf16_t* z = ZT + (size_t)32 * 65536 + (size_t)b * (256 * 4096) + (size_t)ch * 4096 + l2;
            float xv[16];
#pragma unroll
            for (int l1 = 0; l1 < 16; ++l1) xv[l1] = bf2f(z[256 * l1]);
            constexpr float C16[16] = {1.f, 0.92387953251f, 0.70710678119f, 0.38268343237f, 0.f, -0.38268343237f, -0.70710678119f, -0.92387953251f, -1.f, -0.92387953251f, -0.70710678119f, -0.38268343237f, 0.f, 0.38268343237f, 0.70710678119f, 0.92387953251f};
            constexpr float S16[16] = {0.f, 0.38268343237f, 0.70710678119f, 0.92387953251f, 1.f, 0.92387953251f, 0.70710678119f, 0.38268343237f, 0.f, -0.38268343237f, -0.70710678119f, -0.92387953251f, -1.f, -0.92387953251f, -0.70710678119f, -0.38268343237f};
#pragma unroll
            for (int k1 = 0; k1 < 16; ++k1) {
                float yr = 0.f, yi = 0.f;
#pragma unroll
                for (int l1 = 0; l1 < 16; ++l1) { yr += xv[l1] * C16[(l1 * k1) & 15]; yi -= xv[l1] * S16[(l1 * k1) & 15]; }
                float sn, cn; sincos_rev((float)(l2 * k1) * (1.f / 4096.f), sn, cn);
                bf16_t* o = YT + ((size_t)((b * 16 + k1) * 256 + ch)) * 512 + l2;
                o[0] = f2bf(yr * cn + yi * sn); o[256] = f2bf(yi * cn - yr * sn);
            }
        }
        if (c >= 192) CONV_ITEMS(CI1, CI6, (c - 192) * 8 + wave, (G - 192) * 8);
    }
    {
        PHASE_IDS
        GJob<512, 256, 256, 4, 1, 48, 1024 * 512, 256 * 256> js{UH, SG};
        gemm_phase(lds, js, 0, c, G, EpiState{SLOC}, wv);
    }
    {
        PHASE_IDS
        GJob<512, 256, 256, 4, 1, 48, 1024 * 512, 256 * 256> js{UH, SG};
        if (c < 192) {
            asm volatile("s_waitcnt vmcnt(0)" ::: "memory"); __syncthreads();
            Unit un; unit_at(js, c, un); const int g = un.b, pp = lane;
#define SCAN_SHORT4(DIRC) { const f32x2 a16 = APOW[((g * 2 + DIRC) * 17 + 16) * 64 + pp]; float sr[4][16], si[4][16]; \
                    _Pragma("unroll") for (int i = 0; i < 4; ++i) { const int seq = un.pm * 16 + (wave >> 1) + 4 * i; const float* __restrict__ S = SLOC + ((size_t)g * 1024 + seq * 16) * 256 + DIRC * 128 + pp; \
                        _Pragma("unroll") for (int k = 0; k < 16; ++k) { const int cc = DIRC ? (15 - k) : k; sr[i][k] = S[(size_t)cc * 256]; si[i][k] = S[(size_t)cc * 256 + 64]; } } \
                    _Pragma("unroll") for (int i = 0; i < 4; ++i) { const int seq = un.pm * 16 + (wave >> 1) + 4 * i; bf16_t* __restrict__ Hn = UH + ((size_t)g * 1024 + seq * 16) * 512 + 256 + DIRC * 128 + pp; \
                        float hr = 0.f, hi = 0.f; \
                        _Pragma("unroll") for (int k = 0; k < 16; ++k) { const int cc = DIRC ? (15 - k) : k; Hn[(size_t)cc * 512] = f2bf(hr); Hn[(size_t)cc * 512 + 64] = f2bf(hi); \
                            const float nr = a16.x * hr - a16.y * hi + sr[i][k], ni = a16.x * hi + a16.y * hr + si[i][k]; hr = nr; hi = ni; } \
                        const int oi = ((seq * 2 + DIRC) * 48 + g) * 64 + pp; p.out[(size_t)2 * NPR * DM + oi] = hr; p.out[(size_t)2 * NPR * DM + 196608 + oi] = hi; } }
#define SCAN_LONG(DIRC) { const f32x2 a16 = APOW[((g * 2 + DIRC) * 17 + 16) * 64 + pp]; f32x2 a64 = a16; \
                    _Pragma("unroll") for (int q = 0; q < 6; ++q) a64 = (f32x2){a64.x * a64.x - a64.y * a64.y, 2.f * a64.x * a64.y}; \
                    const float* __restrict__ S = SLOC + ((size_t)g * 1024 + row0 + (DIRC ? (255 - sg * 64) : sg * 64)) * 256 + DIRC * 128 + pp; \
                    bf16_t* __restrict__ Hn = UH + ((size_t)g * 1024 + row0 + (DIRC ? (255 - sg * 64) : sg * 64)) * 512 + 256 + DIRC * 128 + pp; \
                    float sr[64], si[64]; \
                    _Pragma("unroll") for (int k = 0; k < 64; ++k) { const int cc = DIRC ? -k : k; sr[k] = S[cc * 256]; si[k] = S[cc * 256 + 64]; } \
                    float er = 0.f, ei = 0.f; \
                    _Pragma("unroll") for (int k = 0; k < 64; ++k) { const float nr = a16.x * er - a16.y * ei + sr[k], ni = a16.x * ei + a16.y * er + si[k]; er = nr; ei = ni; } \
                    Eb[(wave * 64 + lane) * 2] = er; Eb[(wave * 64 + lane) * 2 + 1] = ei; \
                    __syncthreads(); \
                    const int sidx0 = ((b * 2 + DIRC) * 48 + g) * 64 + pp; float hr = p.in[2][sidx0], hi = p.in[3][sidx0]; \
                    for (int j = 0; j < sg; ++j) { const float e0 = Eb[((DIRC * 4 + j) * 64 + lane) * 2], e1 = Eb[((DIRC * 4 + j) * 64 + lane) * 2 + 1]; \
                        const float nr = a64.x * hr - a64.y * hi + e0, ni = a64.x * hi + a64.y * hr + e1; hr = nr; hi = ni; } \
                    _Pragma("unroll") for (int k = 0; k < 64; ++k) { const int cc = DIRC ? -k : k; Hn[cc * 512] = f2bf(hr); Hn[cc * 512 + 64] = f2bf(hi); \
                        const float nr = a16.x * hr - a16.y * hi + sr[k], ni = a16.x * hi + a16.y * hr + si[k]; hr = nr; hi = ni; } \
                    __syncthreads(); }
            if (un.pm < 2) {
                if (wave & 1) SCAN_SHORT4(1) else SCAN_SHORT4(0)
            } else {
                const int b = un.pm - 2, sg = wave & 3, row0 = 512 + b * 256; LAS float* Eb = (LAS float*)lds;
                if (wave >> 2) SCAN_LONG(1) else SCAN_LONG(0)
            }
#undef SCAN_SHORT4
#undef SCAN_LONG
            asm volatile("s_waitcnt vmcnt(0)" ::: "memory"); __syncthreads();
        }
    }
    {
        PHASE_IDS
        GJob<512, 512, 512, 4, 1, 48, 1024 * 512, 256 * 512> jy{UH, ME};
        gemm_phase(lds, jy, 0, c, G, EpiY{GB}, wv);
    }
    GSYNC();

    {
        PHASE_IDS
        GJob<768, 768, 768, 64, 3, 1, 0, 0> jg{GB, WGLU};
        gemm_phase(lds, jg, 0, c, G, EpiGlu{GB, p.in[25], MIX}, wv);
        if (c >= 192) {
            GJob<512, 256, 256, 2, 1, 32, 0, 65536> jp{D512, ZT};
            gemm_phase(lds, jp, 0, c - 192, 64, EpiDft{MIX, 0, 1.f / 128.f}, wv);
            GJob<512, 512, 512, 2, 1, 32, 0, 256 * 512> jsm{D512, YT};
            gemm_phase(lds, jsm, 64, c - 192, 64, EpiDft{MIX, 1, 1.f / 512.f}, wv);
        }
    }
    {
        PHASE_IDS
        (void)0;
    }
    GSYNC();

    {
        PHASE_IDS
        GJob<1280, 1280, 1280, 64, 4, 1, 0, 0> jo{MIX, WOUT0};
        RowStat s1{(float*)(ws + WS_SLOT), (unsigned*)(ws + WS_CNT) + 0 * 1024}, s2{(float*)(ws + WS_SLOT) + 65536, (unsigned*)(ws + WS_CNT) + 1 * 1024};
        gemm_phase(lds, jo, 0, c, G, EpiResNorm{X, HY, BIAS0, MOD, 2048, p.in[9], MOD, 3072, p.in[10], s1, s2, 1}, wv);
    }
    GSYNC();

#pragma unroll 1
    for (int rep = 0; rep < REP_FF1; ++rep) {
        PHASE_IDS
        GJob<1024, 1024, 1024, 64, 16, 1, 0, 0> j1{HY, WFF1};
        gemm_phase(lds, j1, 0, c, G, EpiRelu2{HMID}, wv);
        GSYNC();
    }
    {
        PHASE_IDS
        GJob<4096, 4096, 4096, 64, 4, 1, 0, 0> j2{HMID, WFF2};
        RowStat s1{(float*)(ws + WS_SLOT), (unsigned*)(ws + WS_CNT) + 2 * 1024}, s2{(float*)(ws + WS_SLOT) + 65536, (unsigned*)(ws + WS_CNT) + 3 * 1024};
        gemm_phase(lds, j2, 0, c, G, EpiResNorm{X, HY, nullptr, MOD, 5120, p.in[11], MOD + 3 * 6144, 0, p.in[30], s1, s2, 1}, wv);
    }
    GSYNC();

    {
        PHASE_IDS
        GJob<1024, 1024, 1024, 64, 6, 1, 0, 0> ji{HY, WIN1};
        gemm_phase(lds, ji, 0, c, G, EpiPlain{ZUV, 1536, nullptr, 512}, wv);
    }
    {
        PHASE_IDS
        if (c >= 384 - G) {
            constexpr int I3 = 16 * 64, I4 = 64 * 16; const int nb1 = 2 * G - 384;
            FOLD_ITEMS(16, 528, nb1 * 8 - 1 - ((c - (384 - G)) * 8 + wave), nb1 * 8);
            for (int it = (c - (384 - G)) * 8 + wave; it < I3 + I4; it += nb1 * 8) {
                if (it < I3) transpose_item(p.in[34], 4096, 4096, WFF1, 1024, 0, scr, it, lane);
                else transpose_item(p.in[35], 1024, 1024, WFF2, 4096, 0, scr, it - I3, lane);
            }
        }
    }
    GSYNC();

    {
        PHASE_IDS
        GJob<256, 256, 256, 1, 64, 2, 256 * 256, 16384 * 256> jm{A2, VT};
        if (c < 128) {
            Unit un; unit_at(jm, c, un);
            LAS bf16_t* T = (LAS bf16_t*)lds;
#pragma unroll 1
            for (int r = 0; r < 2; ++r) {
                const int chunk = 2 * un.pn + r;
                const int sub = lane >> 4, q8 = (lane & 15) * 8;
                f32x4 gA[2], gB[2], bA[2], bB[2];
#pragma unroll
                for (int hh = 0; hh < 2; ++hh) { const int h = un.b * 2 + hh; gA[hh] = *(const f32x4*)(p.in[40] + h * 128 + q8); gB[hh] = *(const f32x4*)(p.in[40] + h * 128 + q8 + 4);
                    bA[hh] = *(const f32x4*)(p.in[41] + h * 128 + q8); bB[hh] = *(const f32x4*)(p.in[41] + h * 128 + q8 + 4); }
                u32x4 rv[8];
#pragma unroll
                for (int i = 0; i < 8; ++i) { const int R = i * 32 + wave * 4 + sub, hh = i >> 2, tok = R & 127;
                    rv[i] = *(const u32x4*)(ZUV + (size_t)(chunk * 128 + tok) * 1536 + 1024 + (un.b * 2 + hh) * 128 + q8); }
#pragma unroll
                for (int i = 0; i < 8; ++i) { const int R = i * 32 + wave * 4 + sub, hh = i >> 2, tok = R & 127;
                    float x[8] = {bflo(rv[i].x), bfhi(rv[i].x), bflo(rv[i].y), bfhi(rv[i].y), bflo(rv[i].z), bfhi(rv[i].z), bflo(rv[i].w), bfhi(rv[i].w)};
                    float sm = ((x[0] + x[1]) + (x[2] + x[3])) + ((x[4] + x[5]) + (x[6] + x[7]));
                    sm += __int_as_float(__builtin_amdgcn_ds_swizzle(__float_as_int(sm), 0x041f)); sm += __int_as_float(__builtin_amdgcn_ds_swizzle(__float_as_int(sm), 0x081f));
                    sm += __int_as_float(__builtin_amdgcn_ds_swizzle(__float_as_int(sm), 0x101f)); sm += __int_as_float(__builtin_amdgcn_ds_swizzle(__float_as_int(sm), 0x201f));
                    const float mu = sm * (1.f / 128.f); float sq = 0.f;
#pragma unroll
                    for (int e = 0; e < 8; ++e) { x[e] -= mu; sq += x[e] * x[e]; }
                    sq += __int_as_float(__builtin_amdgcn_ds_swizzle(__float_as_int(sq), 0x041f)); sq += __int_as_float(__builtin_amdgcn_ds_swizzle(__float_as_int(sq), 0x081f));
                    sq += __int_as_float(__builtin_amdgcn_ds_swizzle(__float_as_int(sq), 0x101f)); sq += __int_as_float(__builtin_amdgcn_ds_swizzle(__float_as_int(sq), 0x201f));
                    const float rstd = __builtin_amdgcn_rsqf(sq * (1.f / 128.f) + EPS);
                    const f32x4 ga = gA[hh], gb = gB[hh], ba = bA[hh], bb = bB[hh];
                    u32x4 w4; w4.x = pk2(x[0] * rstd * ga[0] + ba[0], x[1] * rstd * ga[1] + ba[1]); w4.y = pk2(x[2] * rstd * ga[2] + ba[2], x[3] * rstd * ga[3] + ba[3]);
                    w4.z = pk2(x[4] * rstd * gb[0] + bb[0], x[5] * rstd * gb[1] + bb[1]); w4.w = pk2(x[6] * rstd * gb[2] + bb[2], x[7] * rstd * gb[3] + bb[3]);
                    *(LAS u32x4*)(T + (hh * 128 + tok) * 136 + q8) = w4; }
                __syncthreads();
                { const int hh = tid >> 8, seg = (tid >> 7) & 1, d = tid & 127; const LAS bf16_t* sp = T + (hh * 128 + seg * 64) * 136 + d;
                  bf16_t* dst = VT + (size_t)un.b * ((size_t)16384 * 256) + (size_t)(chunk * 128 + d) * 256 + hh * 128 + seg * 64;
#pragma unroll
                  for (int q = 0; q < 8; ++q) { u32x4 o;
                      o.x = (unsigned)sp[(q * 8 + 0) * 136] | ((unsigned)sp[(q * 8 + 1) * 136] << 16); o.y = (unsigned)sp[(q * 8 + 2) * 136] | ((unsigned)sp[(q * 8 + 3) * 136] << 16);
                      o.z = (unsigned)sp[(q * 8 + 4) * 136] | ((unsigned)sp[(q * 8 + 5) * 136] << 16); o.w = (unsigned)sp[(q * 8 + 6) * 136] | ((unsigned)sp[(q * 8 + 7) * 136] << 16);
                      *(u32x4*)(dst + q * 8) = o; } }
                __syncthreads();
            }
            asm volatile("s_waitcnt vmcnt(0)" ::: "memory");
            __syncthreads();
        } else {
            LAS bf16_t* R = (LAS bf16_t*)lds;
            for (int tile = c - 128; tile < 256; tile += 128) {
                const int token0 = tile * 64; int base, L; if (token0 < NPR) { base = token0 & ~255; L = 256; } else { base = NPR + ((token0 - NPR) & ~4095); L = 4096; }
                const int t0 = token0 - base;
                { u32x4 rv[10];
#pragma unroll
                  for (int k = 0; k < 10; ++k) { const int r = wave * 10 + k, t = t0 - 8 + r; rv[k] = (u32x4){0u, 0u, 0u, 0u};
                      if (t >= 0 && t < L) rv[k] = *(const u32x4*)(ZUV + (size_t)(base + t) * 1536 + lane * 8); }
#pragma unroll
                  for (int k = 0; k < 10; ++k) *(LAS u32x4*)(R + (wave * 10 + k) * 512 + lane * 8) = rv[k]; }
                __syncthreads();
                { const int hs = tid >> 8, cp = tid & 255, half = 1 << (cp >> 6); const LAS unsigned* Rc = (const LAS unsigned*)R + cp;
                  float s0 = 0.f, s1 = 0.f; const int i0 = hs * 32;
                  for (int r = i0 + 8 - half; r < i0 + 8 + half; ++r) { const unsigned w = Rc[r * 256]; s0 += bflo(w); s1 += bfhi(w); }
                  bf16_t* dst = MIX + (size_t)(token0 + i0) * 1024 + 2 * cp;
#pragma unroll 4
                  for (int i = i0; i < i0 + 32; ++i) { const int t = t0 + i; const int lo = (t - half) > 0 ? (t - half) : 0, hi = (t + half) < L ? (t + half) : L;
                      const unsigned wc = Rc[(i + 8) * 256]; const float inv = __builtin_amdgcn_rcpf((float)(hi - lo));
                      *(unsigned*)(dst + (size_t)(i - i0) * 1024) = pk2(s0 * inv - bflo(wc), s1 * inv - bfhi(wc));
                      const unsigned wa = Rc[(i + 8 + half) * 256], ws_ = Rc[(i + 8 - half) * 256]; s0 += bflo(wa) - bflo(ws_); s1 += bfhi(wa) - bfhi(ws_); } }
                __syncthreads();
            }
        }
        gemm_phase(lds, jm, 0, c, G, EpiGmlp{ZUV, p.in[43], MIX}, wv);
    }
    GSYNC();

    {
        PHASE_IDS
        GJob<1024, 1024, 1024, 64, 4, 1, 0, 0> jo{MIX, WOUT1};
        RowStat s1{(float*)(ws + WS_SLOT), (unsigned*)(ws + WS_CNT) + 4 * 1024}, s2{(float*)(ws + WS_SLOT) + 65536, (unsigned*)(ws + WS_CNT) + 5 * 1024};
        gemm_phase(lds, jo, 0, c, G, EpiResNorm{X, HY, nullptr, MOD + 3 * 6144, 2048, p.in[31], MOD + 3 * 6144, 3072, p.in[32], s1, s2, 1}, wv);
    }
    GSYNC();
#pragma unroll 1
    for (int rep = 0; rep < REP_FF1; ++rep) {
        PHASE_IDS
        GJob<1024, 1024, 1024, 64, 16, 1, 0, 0> j1{HY, WFF1};
        gemm_phase(lds, j1, 0, c, G, EpiRelu2{HMID}, wv);
        GSYNC();
    }
    {
        PHASE_IDS
        GJob<4096, 4096, 4096, 64, 4, 1, 0, 0> j2{HMID, WFF2};
        RowStat s1{(float*)(ws + WS_SLOT), (unsigned*)(ws + WS_CNT) + 6 * 1024}, s2{(float*)(ws + WS_SLOT) + 65536, (unsigned*)(ws + WS_CNT) + 7 * 1024};
        gemm_phase(lds, j2, 0, c, G, EpiResNorm{X, HY, nullptr, MOD + 3 * 6144, 5120, p.in[33], nullptr, 0, nullptr, s1, s2, 0}, wv);
    }
}

extern "C" void kernel_launch(void* const* d_in, const int* in_sizes, int n_in, void* d_out, int out_size, void* d_ws, size_t ws_size, hipStream_t stream) {
    static int grid_blocks = 0;
    if (grid_blocks == 0) {
        if (n_in != 44 || ws_size < WS_END) { fprintf(stderr, "kernel_launch: expected 44 inputs and >= %zu bytes of workspace, got %d / %zu\n", (size_t)WS_END, n_in, ws_size); grid_blocks = -1; return; }
        int dev = 0, cus = 0, per_cu = 0;
        (void)hipGetDevice(&dev);
        (void)hipDeviceGetAttribute(&cus, hipDeviceAttributeMultiprocessorCount, dev);
        if (hipFuncSetAttribute((const void*)mega_fwd, hipFuncAttributeMaxDynamicSharedMemorySize, LDS_BYTES) != hipSuccess) { fprintf(stderr, "kernel_launch: hipFuncSetAttribute failed\n"); grid_blocks = -1; return; }
        (void)hipOccupancyMaxActiveBlocksPerMultiprocessor(&per_cu, (const void*)mega_fwd, 512, LDS_BYTES);
        if (per_cu < 1) { fprintf(stderr, "kernel_launch: occupancy query says %d blocks per CU\n", per_cu); per_cu = 1; }
        (void)hipGetLastError();
        grid_blocks = cus;
        if (grid_blocks != 256) { fprintf(stderr, "kernel_launch: built for a 256-CU device (the fused norm epilogues need exactly 256 workgroups), got %d CUs\n", cus); grid_blocks = -1; return; }
    }
    if (grid_blocks <= 0) return;
    if (hipMemsetAsync((char*)d_ws + WS_BAR, 0, WS_ZERO_BYTES, stream) != hipSuccess) { fprintf(stderr, "kernel_launch: memset of the barrier words failed\n"); return; }
    if (hipMemsetAsync((char*)d_ws + WS_MOD, 0, 147456, stream) != hipSuccess) { fprintf(stderr, "kernel_launch: memset of the modulation accumulators failed\n"); return; }
    Params p{};
    for (int i = 0; i < 44; ++i) p.in[i] = (const float*)d_in[i];
    p.out = (float*)d_out; p.ws = (unsigned char*)d_ws;
    void* args[] = {&p};
    hipError_t e = hipLaunchCooperativeKernel((const void*)mega_fwd, dim3(grid_blocks), dim3(512), args, LDS_BYTES, stream);
    if (e != hipSuccess) fprintf(stderr, "cooperative launch failed: %s (grid %d)\n", hipGetErrorString(e), grid_blocks);
}
```

```cpp
#include <hip/hip_runtime.h>
#include <hip/hip_cooperative_groups.h>
#include <cstdio>
namespace cg = cooperative_groups;
#define REP_P0 1
#define REP_P1 1
#define REP_FF1 1
#define REP_FF2 1
#define EXTRA_SYNC 0

#define LAS __attribute__((address_space(3)))
typedef unsigned short bf16_t;
typedef short bf16x8 __attribute__((ext_vector_type(8)));
typedef float f32x4 __attribute__((ext_vector_type(4)));
typedef float f32x2 __attribute__((ext_vector_type(2)));
typedef unsigned u32x4 __attribute__((ext_vector_type(4)));
typedef unsigned u32x2 __attribute__((ext_vector_type(2)));

constexpr int NTOK = 16384, DM = 1024, NPR = 8192, DFF = 4096;
constexpr float EPS = 1e-6f;
constexpr int LDS_BYTES = 131072 + 16;
constexpr size_t MiB = 1048576;
constexpr size_t WS_WFF1 = 0;
constexpr size_t WS_WFF2 = WS_WFF1 + 8 * MiB;
constexpr size_t WS_WIN0 = WS_WFF2 + 8 * MiB;
constexpr size_t WS_WGLU = WS_WIN0 + 2 * MiB;
constexpr size_t WS_WOUT0 = WS_WGLU + 1179648;
constexpr size_t WS_WIN1 = WS_WOUT0 + 2621440;
constexpr size_t WS_WOUT1 = WS_WIN1 + 3 * MiB;
constexpr size_t WS_ME = WS_WOUT1 + 2 * MiB;
constexpr size_t WS_SG = WS_ME + 12 * MiB;
constexpr size_t WS_D512 = WS_SG + 6 * MiB;
constexpr size_t WS_A2 = WS_D512 + 524288;
constexpr size_t WS_MOD = WS_A2 + 262144;
constexpr size_t WS_APOW = WS_MOD + 147456;
constexpr size_t WS_BBT = WS_APOW + 835584;
constexpr size_t WS_KTAB = WS_BBT + 786432;
constexpr size_t WS_CSW = WS_KTAB + 1572864;
constexpr size_t WS_BIAS0 = WS_CSW + 131072;
constexpr size_t WS_HY = WS_BIAS0 + 4096;
constexpr size_t WS_MIX = WS_HY + 32 * MiB;
constexpr size_t WS_BIG = WS_MIX + 40 * MiB;
constexpr size_t WS_UH = WS_BIG;
constexpr size_t WS_SLOC = WS_BIG + 48 * MiB;
constexpr size_t WS_G = WS_HY;
constexpr size_t WS_ZT = WS_BIG + 96 * MiB;
constexpr size_t WS_YT = WS_BIG + 104 * MiB;
constexpr size_t WS_ZUV = WS_BIG;
constexpr size_t WS_VT = WS_BIG + 48 * MiB;
constexpr size_t WS_HMID = WS_BIG;
constexpr size_t WS_BAR = WS_BIG + 128 * MiB;
constexpr size_t WS_CNT = WS_BAR + 16384;
constexpr size_t WS_SLOT = WS_CNT + 32768;
constexpr size_t WS_END = WS_SLOT + 2 * 262144;
constexpr size_t WS_ZERO_BYTES = 16384 + 32768;

struct Params { const float* in[44]; float* out; unsigned char* ws; };
#define PIN(k) ([&]() -> const float* { int k_ = (k); asm volatile("" : "+s"(k_)); return p.in[k_]; }())

__device__ __forceinline__ unsigned pk2(float lo, float hi) { unsigned r; asm("v_cvt_pk_bf16_f32 %0, %1, %2" : "=v"(r) : "v"(lo), "v"(hi)); return r; }
__device__ __forceinline__ bf16_t f2bf(float f) { return (bf16_t)(pk2(f, 0.f) & 0xffffu); }
__device__ __forceinline__ float bf2f(bf16_t b) { return __uint_as_float(((unsigned)b) << 16); }
__device__ __forceinline__ float bflo(unsigned w) { return __uint_as_float(w << 16); }
__device__ __forceinline__ float bfhi(unsigned w) { return __uint_as_float(w & 0xffff0000u); }
__device__ __forceinline__ float fexp(float x) { return __builtin_amdgcn_exp2f(x * 1.4426950408889634f); }
__device__ __forceinline__ float sigm(float x) { return __builtin_amdgcn_rcpf(1.f + fexp(-x)); }
__device__ __forceinline__ float gelu_t(float x) { const float u = 0.7978845608028654f * (x + 0.044715f * x * x * x); return x * sigm(2.f * u); }
__device__ __forceinline__ void sincos_rev(float rev, float& s, float& c) { const float f = rev - floorf(rev); s = __builtin_amdgcn_sinf(f); c = __builtin_amdgcn_cosf(f); }
__device__ __forceinline__ float wave_sum(float v) {
    v += __int_as_float(__builtin_amdgcn_ds_swizzle(__float_as_int(v), 0x041f));
    v += __int_as_float(__builtin_amdgcn_ds_swizzle(__float_as_int(v), 0x081f));
    v += __int_as_float(__builtin_amdgcn_ds_swizzle(__float_as_int(v), 0x101f));
    v += __int_as_float(__builtin_amdgcn_ds_swizzle(__float_as_int(v), 0x201f));
    v += __int_as_float(__builtin_amdgcn_ds_swizzle(__float_as_int(v), 0x401f));
    return __int_as_float(__builtin_amdgcn_readlane(__float_as_int(v), 0)) + __int_as_float(__builtin_amdgcn_readlane(__float_as_int(v), 32));
}
#define LDS_WAIT() asm volatile("s_waitcnt lgkmcnt(0)" ::: "memory")
__device__ __forceinline__ int tid_fresh(int wv) { unsigned z = 0u; asm volatile("" : "+v"(z)); return wv * 64 + (int)__builtin_amdgcn_mbcnt_hi(~0u, __builtin_amdgcn_mbcnt_lo(~0u, z)); }


#define XB_TMO      128
#define XB_XCNT(j)  (256  + 64 * (j))
#define XB_XSUB(j)  (1280 + 64 * (j))
#define XB_XGEN(j)  (2304 + 64 * (j))
#define XB_TOP      3328
#define XB_TOPGEN   3392
#define XCD_BAR_WORDS 3456
#define XB_SPIN_CAP (1u << 18)
__device__ __forceinline__ unsigned xb_ld(unsigned* p)              { return __hip_atomic_load(p, __ATOMIC_RELAXED, __HIP_MEMORY_SCOPE_AGENT); }
__device__ __forceinline__ unsigned xb_add(unsigned* p, unsigned v) { return __hip_atomic_fetch_add(p, v, __ATOMIC_RELAXED, __HIP_MEMORY_SCOPE_AGENT); }
__device__ __forceinline__ unsigned xb_xcc_id() { return (unsigned)__builtin_amdgcn_s_getreg((3 << 11) | 20) & 0xFu; }
#define XB_SPIN(cond, bar) do { unsigned _sp = 0; while (cond) { __builtin_amdgcn_s_sleep(1); \
    if ((++_sp & 255u) == 0u) { if (xb_ld(&(bar)[XB_TMO])) break; if (_sp > XB_SPIN_CAP) { atomicAdd(&(bar)[XB_TMO], 1u); break; } } } } while (0)
__device__ __forceinline__ void xcd_barrier_complete(unsigned* bar, unsigned x, unsigned& nloc, unsigned& nx) {
    const unsigned G = gridDim.x * gridDim.y * gridDim.z;
    unsigned sum, cnt, mine, sp = 0u;
    for (;;) {
        sum = 0u; cnt = 0u; mine = 0u;
#pragma unroll
        for (unsigned j = 0; j < 16; ++j) { const unsigned c = xb_ld(&bar[XB_XCNT(j)]); sum += c; cnt += (c > 0u) ? 1u : 0u; mine = (j == x) ? c : mine; }
        if (sum == G) break;
        __builtin_amdgcn_s_sleep(1);
        if ((++sp & 255u) == 0u) { if (xb_ld(&bar[XB_TMO])) break; if (sp > XB_SPIN_CAP) { atomicAdd(&bar[XB_TMO], 1u); break; } }
    }
    nloc = mine > 0u ? mine : 1u; nx = cnt > 0u ? cnt : 1u;
}
__device__ __forceinline__ void xcd_barrier(unsigned* bar, volatile LAS unsigned* st, int wv) {
    asm volatile("s_waitcnt vmcnt(0)" ::: "memory");
    __syncthreads();
    if (tid_fresh(wv) == 0) {
        const unsigned x = xb_xcc_id();
        __builtin_amdgcn_s_waitcnt(0);
        unsigned nloc = st[0], nx = st[1];
        if (nloc == 0u) { xcd_barrier_complete(bar, x, nloc, nx); st[0] = nloc; st[1] = nx; }
        const unsigned old = xb_add(&bar[XB_XSUB(x)], 1u);
        const unsigned gen = old / nloc;
        if (old + 1u == (gen + 1u) * nloc) {
            __builtin_amdgcn_fence(__ATOMIC_RELEASE, "agent");
            asm volatile("s_waitcnt vmcnt(0)" ::: "memory");
            const unsigned og = xb_add(&bar[XB_TOP], 1u);
            const unsigned tg = og / nx;
            if (og + 1u == (tg + 1u) * nx) xb_add(&bar[XB_TOPGEN], 1u);
            else XB_SPIN(xb_ld(&bar[XB_TOPGEN]) == tg, bar);
            __builtin_amdgcn_fence(__ATOMIC_ACQUIRE, "agent");
            xb_add(&bar[XB_XGEN(x)], 1u);
            asm volatile("s_waitcnt vmcnt(0)" ::: "memory");
        } else {
            XB_SPIN(xb_ld(&bar[XB_XGEN(x)]) == gen, bar);
            __builtin_amdgcn_fence(__ATOMIC_ACQUIRE, "agent");
            asm volatile("s_waitcnt vmcnt(0)" ::: "memory");
        }
    }
    __syncthreads();
}

constexpr int BM = 256, BK = 64, HALF = 128, HTB = HALF * BK * 2;
__device__ __forceinline__ int lds_byte(int r, int c) { const int st = (r >> 4) * 2 + (c >> 5), rr = r & 15, cc = c & 31, ob = rr * 64 + cc * 2; return st * 1024 + (ob ^ (((ob >> 9) & 1) << 5)); }
__device__ __forceinline__ void stage_rc(int b, int& R, int& C) { const int st = b / 1024, sb = b % 1024, swz = sb ^ (((sb >> 9) & 1) << 5); R = (st >> 1) * 16 + swz / 64; C = (st & 1) * 32 + (swz % 64) / 2; }

__device__ __forceinline__ int perm32(int rho) { const int n = rho >> 4, i = rho & 15; return 8 * (i >> 2) + 4 * n + (i & 3); }
template <class E> struct EpiPerm { static constexpr bool v = false; };
template <int LDA, int LDB, int KK, int NM, int NN, int NBATCH, long SA, long SB>
struct GJob { const bf16_t* A; const bf16_t* B; static constexpr int lda = LDA, ldb = LDB, K = KK, nM = NM, nN = NN, nB = NBATCH; static constexpr long sA = SA, sB = SB; };
struct Unit { int b, pm, pn; };
template <class J>
__device__ __forceinline__ bool unit_at(const J& g, int u, Unit& o) {
    const int per = g.nM * g.nN, nwg = per * g.nB;
    if (u >= nwg) return false;
    int wgid = u; { const int q = nwg / 8, r = nwg % 8, xcd = wgid % 8, off = wgid / 8; wgid = (xcd < r ? xcd * (q + 1) : r * (q + 1) + (xcd - r) * q) + off; }
    o.b = wgid / per; const int w = wgid % per;
    const int nig = 4 * g.nN, gid = w / nig, fm = gid * 4, gsz = (g.nM - fm) < 4 ? (g.nM - fm) : 4;
    o.pm = fm + ((w % nig) % gsz); o.pn = (w % nig) / gsz; return true;
}

#define EPI_LOOP(...) \
    _Pragma("unroll") for (int ai = 0; ai < 2; ++ai) _Pragma("unroll") for (int m = 0; m < 4; ++m) { const int row = u.pm * 256 + ai * 128 + wr * 64 + m * 16 + fr; \
    _Pragma("unroll") for (int bj = 0; bj < 2; ++bj) _Pragma("unroll") for (int n = 0; n < 2; ++n) { const int col = u.pn * 256 + bj * 128 + wc * 32 + n * 16 + 4 * fq; const f32x4 v = acc[ai][bj][m][n]; __VA_ARGS__ } }
#define EPI_SIG const f32x4 (&acc)[2][2][4][2], const Unit& u, int wr, int wc, int fr, int fq

__device__ __forceinline__ void st_bf4(bf16_t* p, f32x4 v) { u32x2 w; w.x = pk2(v[0], v[1]); w.y = pk2(v[2], v[3]); *(u32x2*)p = w; }

struct EpiU {
    static constexpr bool AFTER_DRAIN = false;
    bf16_t* UH;
    __device__ __forceinline__ void operator()(EPI_SIG) const {
#pragma unroll
        for (int ai = 0; ai < 2; ++ai)
#pragma unroll
            for (int m = 0; m < 4; ++m) { const int row = u.pm * 256 + ai * 128 + wr * 64 + m * 16 + fr;
#pragma unroll
                for (int bj = 0; bj < 2; ++bj) { const int col = u.pn * 256 + bj * 128 + wc * 32 + 8 * fq, g = col >> 4, h = col & 15;
                    const f32x4 a = acc[ai][bj][m][0], b = acc[ai][bj][m][1];
                    u32x4 w; w.x = pk2(a[0], a[1]); w.y = pk2(a[2], a[3]); w.z = pk2(b[0], b[1]); w.w = pk2(b[2], b[3]);
                    *(u32x4*)(UH + ((size_t)g * 1024 + (row >> 4)) * 512 + (row & 15) * 16 + h) = w; } }
    }
};
template <> struct EpiPerm<EpiU> { static constexpr bool v = true; };
struct EpiZt {
    static constexpr bool AFTER_DRAIN = false;
    bf16_t* ZT;
    __device__ __forceinline__ void operator()(EPI_SIG) const { EPI_LOOP(
        const size_t off = (col < NPR) ? ((size_t)(col >> 8) * 65536 + (size_t)row * 256 + (col & 255)) : ((size_t)32 * 65536 + (size_t)((col - NPR) >> 12) * (256 * 4096) + (size_t)row * 4096 + ((col - NPR) & 4095));
        st_bf4(ZT + off, v); ) }
};
struct EpiState {
    static constexpr bool AFTER_DRAIN = false;
    float* S;
    __device__ __forceinline__ void operator()(EPI_SIG) const { EPI_LOOP( *(f32x4*)(S + ((size_t)u.b * 1024 + row) * 256 + col) = v; ) }
};
struct EpiY {
    static constexpr bool AFTER_DRAIN = false;
    bf16_t* G;
    __device__ __forceinline__ void operator()(EPI_SIG) const {
#pragma unroll
        for (int ai = 0; ai < 2; ++ai)
#pragma unroll
            for (int m = 0; m < 4; ++m) { const int row = u.pm * 256 + ai * 128 + wr * 64 + m * 16 + fr;
#pragma unroll
                for (int bj = 0; bj < 2; ++bj) { const int col = u.pn * 256 + bj * 128 + wc * 32 + 8 * fq;
                    const f32x4 a = acc[ai][bj][m][0], b = acc[ai][bj][m][1];
                    u32x4 w; w.x = pk2(gelu_t(a[0]), gelu_t(a[1])); w.y = pk2(gelu_t(a[2]), gelu_t(a[3])); w.z = pk2(gelu_t(b[0]), gelu_t(b[1])); w.w = pk2(gelu_t(b[2]), gelu_t(b[3]));
                    *(u32x4*)(G + (size_t)(row * 16 + (col >> 4)) * 768 + u.b * 16 + (col & 15)) = w; } }
    }
};
struct EpiGlu {
    static constexpr bool AFTER_DRAIN = false;
    const bf16_t* G; const float* bglu; bf16_t* MIX;
    __device__ __forceinline__ void operator()(EPI_SIG) const {
        f32x4 bb[2][2];
#pragma unroll
        for (int bj = 0; bj < 2; ++bj) { const int col = u.pn * 256 + bj * 128 + wc * 32 + 8 * fq; bb[bj][0] = *(const f32x4*)(bglu + col); bb[bj][1] = *(const f32x4*)(bglu + col + 4); }
#pragma unroll
        for (int ai = 0; ai < 2; ++ai) {
            u32x4 gw[4][2];
#pragma unroll
            for (int m = 0; m < 4; ++m)
#pragma unroll
                for (int bj = 0; bj < 2; ++bj) { const int row = u.pm * 256 + ai * 128 + wr * 64 + m * 16 + fr, col = u.pn * 256 + bj * 128 + wc * 32 + 8 * fq;
                    gw[m][bj] = *(const u32x4*)(G + (size_t)row * 768 + col); }
#pragma unroll
            for (int m = 0; m < 4; ++m)
#pragma unroll
                for (int bj = 0; bj < 2; ++bj) { const int row = u.pm * 256 + ai * 128 + wr * 64 + m * 16 + fr, col = u.pn * 256 + bj * 128 + wc * 32 + 8 * fq;
                    const f32x4 a = acc[ai][bj][m][0], b = acc[ai][bj][m][1]; const u32x4 g4 = gw[m][bj];
                    u32x4 w; w.x = pk2(bflo(g4.x) * sigm(a[0] + bb[bj][0][0]), bfhi(g4.x) * sigm(a[1] + bb[bj][0][1])); w.y = pk2(bflo(g4.y) * sigm(a[2] + bb[bj][0][2]), bfhi(g4.y) * sigm(a[3] + bb[bj][0][3]));
                    w.z = pk2(bflo(g4.z) * sigm(b[0] + bb[bj][1][0]), bfhi(g4.z) * sigm(b[1] + bb[bj][1][1])); w.w = pk2(bflo(g4.w) * sigm(b[2] + bb[bj][1][2]), bfhi(g4.w) * sigm(b[3] + bb[bj][1][3]));
                    *(u32x4*)(MIX + (size_t)row * 1280 + col) = w; }
        }
    }
};
struct EpiDft {
    static constexpr bool AFTER_DRAIN = false;
    bf16_t* MIX; int sample; float scale;
    __device__ __forceinline__ void operator()(EPI_SIG) const { EPI_LOOP(
        const int cs = row >> 8, k2 = row & 255;
        const int token = sample ? (NPR + (u.b >> 4) * 4096 + (u.b & 15) + 16 * k2) : (u.b * 256 + k2);
        st_bf4(MIX + (size_t)token * 1280 + 768 + (col >> 6) * 128 + cs * 64 + (col & 63), v * scale); ) }
};
struct EpiPlain {
    static constexpr bool AFTER_DRAIN = false;
    bf16_t* O; int ld; const float* bias; int gelu_from;
    __device__ __forceinline__ void operator()(EPI_SIG) const {
        const bool dog = (u.pn * 256) >= gelu_from;
#pragma unroll
        for (int ai = 0; ai < 2; ++ai)
#pragma unroll
            for (int m = 0; m < 4; ++m) { const int row = u.pm * 256 + ai * 128 + wr * 64 + m * 16 + fr;
#pragma unroll
                for (int bj = 0; bj < 2; ++bj) { const int col = u.pn * 256 + bj * 128 + wc * 32 + 8 * fq;
                    f32x4 a = acc[ai][bj][m][0], b = acc[ai][bj][m][1];
                    if (dog) {
#pragma unroll
                        for (int e = 0; e < 4; ++e) { a[e] = gelu_t(a[e]); b[e] = gelu_t(b[e]); } }
                    u32x4 w; w.x = pk2(a[0], a[1]); w.y = pk2(a[2], a[3]); w.z = pk2(b[0], b[1]); w.w = pk2(b[2], b[3]);
                    *(u32x4*)(O + (size_t)row * ld + col) = w; } }
    }
};
struct EpiRelu2 {
    static constexpr bool AFTER_DRAIN = false;
    bf16_t* O;
    __device__ __forceinline__ void operator()(EPI_SIG) const {
#pragma unroll
        for (int ai = 0; ai < 2; ++ai)
#pragma unroll
            for (int m = 0; m < 4; ++m) { const int row = u.pm * 256 + ai * 128 + wr * 64 + m * 16 + fr;
#pragma unroll
                for (int bj = 0; bj < 2; ++bj) { const int col = u.pn * 256 + bj * 128 + wc * 32 + 8 * fq;
                    f32x4 a = acc[ai][bj][m][0], b = acc[ai][bj][m][1];
#pragma unroll
                    for (int e = 0; e < 4; ++e) { a[e] = fmaxf(a[e], 0.f); b[e] = fmaxf(b[e], 0.f); }
                    a = a * a; b = b * b;
                    u32x4 w; w.x = pk2(a[0], a[1]); w.y = pk2(a[2], a[3]); w.z = pk2(b[0], b[1]); w.w = pk2(b[2], b[3]);
                    *(u32x4*)(O + (size_t)row * DFF + col) = w; } }
    }
};
template <> struct EpiPerm<EpiRelu2> { static constexpr bool v = true; };
template <> struct EpiPerm<EpiPlain> { static constexpr bool v = true; };
template <> struct EpiPerm<EpiY> { static constexpr bool v = true; };
template <> struct EpiPerm<EpiGlu> { static constexpr bool v = true; };
struct EpiResNorm;
template <> struct EpiPerm<EpiResNorm> { static constexpr bool v = true; };
struct EpiGmlp {
    static constexpr bool AFTER_DRAIN = false;
    const bf16_t* ZUV; const float* bs; bf16_t* MIX;
    __device__ __forceinline__ void operator()(EPI_SIG) const {
#pragma unroll
        for (int ai = 0; ai < 2; ++ai) {
            const int head = u.b * 2 + ai;
#pragma unroll
            for (int m = 0; m < 4; ++m) { const int q = wr * 64 + m * 16 + fr; const float b = bs[head * 128 + q];
                u32x4 uw[2];
#pragma unroll
                for (int bj = 0; bj < 2; ++bj) { const int col = u.pn * 256 + bj * 128 + wc * 32 + 8 * fq, token = (col >> 7) * 128 + q, d = col & 127;
                    uw[bj] = *(const u32x4*)(ZUV + (size_t)token * 1536 + 512 + head * 128 + d); }
#pragma unroll
                for (int bj = 0; bj < 2; ++bj) { const int col = u.pn * 256 + bj * 128 + wc * 32 + 8 * fq, token = (col >> 7) * 128 + q, d = col & 127;
                    const f32x4 va = acc[ai][bj][m][0], vb = acc[ai][bj][m][1]; const u32x4 w4 = uw[bj];
                    u32x4 o; o.x = pk2(bflo(w4.x) * (va[0] + b), bfhi(w4.x) * (va[1] + b)); o.y = pk2(bflo(w4.y) * (va[2] + b), bfhi(w4.y) * (va[3] + b));
                    o.z = pk2(bflo(w4.z) * (vb[0] + b), bfhi(w4.z) * (vb[1] + b)); o.w = pk2(bflo(w4.w) * (vb[2] + b), bfhi(w4.w) * (vb[3] + b));
                    *(u32x4*)(MIX + (size_t)token * 1024 + 512 + head * 128 + d) = o; }
                asm volatile("" ::: "memory"); }
        }
    }
};
template <> struct EpiPerm<EpiGmlp> { static constexpr bool v = true; };

struct RowStat {
    float* slots; unsigned* cnt;
    __device__ __forceinline__ void run(const f32x4 (&v)[2][2][4][2], const Unit& u, int wr, int wc, int fr, int fq, LAS unsigned char* lds, int tid) const {
        LAS float* P = (LAS float*)lds;
        LAS float* S = (LAS float*)(lds + 16384);
#pragma unroll
        for (int ai = 0; ai < 2; ++ai)
#pragma unroll
            for (int m = 0; m < 4; ++m) { float sq = 0.f;
#pragma unroll
                for (int bj = 0; bj < 2; ++bj)
#pragma unroll
                    for (int n = 0; n < 2; ++n) { const f32x4 x = v[ai][bj][m][n]; sq += (x[0] * x[0] + x[1] * x[1]) + (x[2] * x[2] + x[3] * x[3]); }
                P[(ai * 128 + wr * 64 + m * 16 + fr) * 16 + wc * 4 + fq] = sq; }
        asm volatile("s_waitcnt lgkmcnt(0)" ::: "memory"); __builtin_amdgcn_s_barrier(); asm volatile("" ::: "memory");
        if (tid < 256) {
            const LAS f32x4* pr = (const LAS f32x4*)(P + tid * 16); const f32x4 a = pr[0], b = pr[1], c2 = pr[2], d = pr[3];
            const float tot = ((a[0] + a[1]) + (a[2] + a[3])) + ((b[0] + b[1]) + (b[2] + b[3])) + ((c2[0] + c2[1]) + (c2[2] + c2[3])) + ((d[0] + d[1]) + (d[2] + d[3]));
            __hip_atomic_store(slots + ((size_t)(u.pm * 256 + tid) * 4 + u.pn), tot, __ATOMIC_RELAXED, __HIP_MEMORY_SCOPE_AGENT);
            asm volatile("s_waitcnt vmcnt(0)" ::: "memory");
            if ((tid & 63) == 0) __hip_atomic_fetch_add(cnt + 16 * u.pm, 1u, __ATOMIC_RELAXED, __HIP_MEMORY_SCOPE_AGENT);
        }
        if (tid < 64) {
            unsigned sp = 0;
            while ((unsigned)__builtin_amdgcn_readfirstlane(__hip_atomic_load(cnt + 16 * u.pm, __ATOMIC_RELAXED, __HIP_MEMORY_SCOPE_AGENT)) < 16u) { __builtin_amdgcn_s_sleep(1); if (++sp > (1u << 22)) break; }
            __builtin_amdgcn_fence(__ATOMIC_ACQUIRE, "agent");
        }
        asm volatile("s_waitcnt vmcnt(0) lgkmcnt(0)" ::: "memory"); __builtin_amdgcn_s_barrier(); asm volatile("" ::: "memory");
        if (tid < 256) {
            const float* sl = slots + (size_t)(u.pm * 256 + tid) * 4; float tot = 0.f;
#pragma unroll
            for (int t = 0; t < 4; ++t) tot += __hip_atomic_load(sl + t, __ATOMIC_RELAXED, __HIP_MEMORY_SCOPE_AGENT);
            S[tid] = __builtin_amdgcn_rsqf(tot * (1.f / 1024.f) + EPS);
        }
        asm volatile("s_waitcnt vmcnt(0) lgkmcnt(0)" ::: "memory"); __builtin_amdgcn_s_barrier(); asm volatile("" ::: "memory");
    }
};
struct EpiResNorm {
    static constexpr bool AFTER_DRAIN = true;
    float* X; bf16_t* H; const float* bias; const float* mod; int gate_off; const float* g_post; const float* mod_next; int pre_off; const float* g_pre; RowStat st1, st2; int next;
    __device__ __forceinline__ void fused(f32x4 (&acc)[2][2][4][2], const Unit& u, int wr, int wc, int fr, int fq, LAS unsigned char* lds, int tid) const {
        const LAS float* S = (const LAS float*)(lds + 16384);
        const int cond = (u.pm < 32) ? 0 : 1 + ((u.pm - 32) >> 4);
        const int col0 = u.pn * 256 + wc * 32 + 8 * fq;
        if (bias) {
#pragma unroll
            for (int bj = 0; bj < 2; ++bj)
#pragma unroll
                for (int n = 0; n < 2; ++n) { const f32x4 bv = *(const f32x4*)(bias + col0 + bj * 128 + n * 4);
#pragma unroll
                    for (int ai = 0; ai < 2; ++ai)
#pragma unroll
                        for (int m = 0; m < 4; ++m) acc[ai][bj][m][n] += bv; }
        }
        st1.run(acc, u, wr, wc, fr, fq, lds, tid);
        const float* gt = mod + cond * 6144 + gate_off;
        {
            f32x4 gv[4];
#pragma unroll
            for (int q = 0; q < 4; ++q) { const int co = (q >> 1) * 128 + (q & 1) * 4; gv[q] = *(const f32x4*)(gt + col0 + co) * *(const f32x4*)(g_post + col0 + co); }
#pragma unroll
            for (int ai = 0; ai < 2; ++ai)
#pragma unroll
                for (int mp = 0; mp < 2; ++mp) {
                    f32x4 xv[2][4];
#pragma unroll
                    for (int mm = 0; mm < 2; ++mm) { const int r = ai * 128 + wr * 64 + (mp * 2 + mm) * 16 + fr; const float* xp = X + (size_t)(u.pm * 256 + r) * DM + col0;
#pragma unroll
                        for (int q = 0; q < 4; ++q) xv[mm][q] = *(const f32x4*)(xp + (q >> 1) * 128 + (q & 1) * 4); }
#pragma unroll
                    for (int mm = 0; mm < 2; ++mm) { const int m = mp * 2 + mm, r = ai * 128 + wr * 64 + m * 16 + fr; const float r1 = S[r]; float* xp = X + (size_t)(u.pm * 256 + r) * DM + col0;
#pragma unroll
                        for (int q = 0; q < 4; ++q) { const f32x4 xn = xv[mm][q] + gv[q] * (acc[ai][q >> 1][m][q & 1] * r1); *(f32x4*)(xp + (q >> 1) * 128 + (q & 1) * 4) = xn; acc[ai][q >> 1][m][q & 1] = xn; } }
                    asm volatile("" ::: "memory"); }
        }
        if (next) {
            st2.run(acc, u, wr, wc, fr, fq, lds, tid);
            const float* sh = mod_next + cond * 6144 + pre_off; const float* sc = sh + 1024;
            f32x4 av[4], s0[4];
#pragma unroll
            for (int q = 0; q < 4; ++q) { const int co = (q >> 1) * 128 + (q & 1) * 4; av[q] = *(const f32x4*)(g_pre + col0 + co) * (1.f + *(const f32x4*)(sc + col0 + co)); s0[q] = *(const f32x4*)(sh + col0 + co); }
#pragma unroll
            for (int ai = 0; ai < 2; ++ai)
#pragma unroll
                for (int m = 0; m < 4; ++m) { const int r = ai * 128 + wr * 64 + m * 16 + fr; const float r2 = S[r]; bf16_t* hp = H + (size_t)(u.pm * 256 + r) * DM + col0;
#pragma unroll
                    for (int bj = 0; bj < 2; ++bj) { const f32x4 h0 = acc[ai][bj][m][0] * r2 * av[2 * bj] + s0[2 * bj], h1 = acc[ai][bj][m][1] * r2 * av[2 * bj + 1] + s0[2 * bj + 1];
                        u32x4 w; w.x = pk2(h0[0], h0[1]); w.y = pk2(h0[2], h0[3]); w.z = pk2(h1[0], h1[1]); w.w = pk2(h1[2], h1[3]); *(u32x4*)(hp + bj * 128) = w; } }
        }
    }
};

template <class J, class Epi>
__device__ __forceinline__ void gemm_phase(LAS unsigned char* lds, const J g, int ubase, int c, int G, const Epi& E, int wv) {
    const int tid = tid_fresh(wv), wid = __builtin_amdgcn_readfirstlane(tid >> 6), lane = tid & 63, wr = wid >> 2, wc = wid & 3, fr = lane & 15, fq = lane >> 4;
    const int K = g.K, nt = K / BK;
    int u0; { int i0 = (ubase > c) ? (ubase - c + G - 1) / G : 0; u0 = c + i0 * G - ubase; }
    Unit cur, nxt; int ui = 0;
    if (!unit_at(g, u0, cur)) return;
    unsigned voffA[2], voffB[2];
#pragma unroll
    for (int i = 0; i < 2; ++i) { int R, C; stage_rc(tid * 16 + i * 8192, R, C); const int Rb = EpiPerm<Epi>::v ? ((R & ~31) + perm32(R & 31)) : R; voffA[i] = (unsigned)(R * g.lda + C) * 2u; voffB[i] = (unsigned)(Rb * g.ldb + C) * 2u; }
    const size_t kstep = (size_t)(BK * 2);
    const size_t hstepA = (size_t)HALF * g.lda * 2, hstepB = (size_t)HALF * g.ldb * 2;
    const unsigned ldsw = (unsigned)wid * 1024u;
    const int aoff = lds_byte(wr * 64 + fr, fq * 8), boff = lds_byte(wc * 32 + fr, fq * 8);
#define PG8_SA(b, h) (((b) * 2 + (h)) * HTB)
#define PG8_SB(b, h) ((4 + (b) * 2 + (h)) * HTB)
#define PG8_STAGE(bufoff, gbase, voff) do { _Pragma("unroll") for (int _i = 0; _i < 2; ++_i) \
        __builtin_amdgcn_global_load_lds((const unsigned*)((const char*)(gbase) + (voff)[_i]), (LAS unsigned*)(lds + (bufoff) + ldsw + _i * 8192), 16, 0, 0); } while (0)
#define PG8_LDA(dst, b, h) do { _Pragma("unroll") for (int m = 0; m < 4; ++m) _Pragma("unroll") for (int k = 0; k < 2; ++k) dst[m][k] = *(const LAS bf16x8*)(lds + PG8_SA(b, h) + aoff + m * 2048 + k * 1024); } while (0)
#define PG8_LDB(dst, b, h) do { _Pragma("unroll") for (int n = 0; n < 2; ++n) _Pragma("unroll") for (int k = 0; k < 2; ++k) dst[n][k] = *(const LAS bf16x8*)(lds + PG8_SB(b, h) + boff + n * 2048 + k * 1024); } while (0)
#define PG8_MMA(ai, bj, At, Bt) do { __builtin_amdgcn_s_setprio(1); _Pragma("unroll") for (int m = 0; m < 4; ++m) _Pragma("unroll") for (int n = 0; n < 2; ++n) _Pragma("unroll") for (int k = 0; k < 2; ++k) \
        acc[ai][bj][m][n] = __builtin_amdgcn_mfma_f32_16x16x32_bf16(Bt[n][k], At[m][k], acc[ai][bj][m][n], 0, 0, 0); __builtin_amdgcn_s_setprio(0); } while (0)
#define PG8_WAIT_V(n) asm volatile("s_waitcnt vmcnt(" #n ")" ::: "memory")
#define PG8_WAIT_L(n) asm volatile("s_waitcnt lgkmcnt(" #n ")" ::: "memory")
#define PG8_BAR __builtin_amdgcn_s_barrier()
#define PG8_SCHED __builtin_amdgcn_sched_barrier(0)
    f32x4 acc[2][2][4][2];
#pragma unroll
    for (int a = 0; a < 2; ++a)
#pragma unroll
        for (int b = 0; b < 2; ++b)
#pragma unroll
            for (int m = 0; m < 4; ++m)
#pragma unroll
                for (int n = 0; n < 2; ++n) acc[a][b][m][n] = (f32x4){0.f, 0.f, 0.f, 0.f};
    bf16x8 At[4][2], B0[2][2], B1[2][2];
    const char* cA = (const char*)(g.A + (size_t)cur.b * g.sA) + (size_t)cur.pm * 2 * hstepA;
    const char* cB = (const char*)(g.B + (size_t)cur.b * g.sB) + (size_t)cur.pn * 2 * hstepB;
    PG8_STAGE(PG8_SB(0, 0), cB, voffB); PG8_STAGE(PG8_SA(0, 0), cA, voffA); PG8_STAGE(PG8_SB(0, 1), cB + hstepB, voffB); PG8_STAGE(PG8_SA(0, 1), cA + hstepA, voffA);
    if (wr == 1) PG8_BAR;
    PG8_WAIT_V(4); PG8_BAR;
    PG8_STAGE(PG8_SB(1, 0), cB + kstep, voffB); PG8_STAGE(PG8_SA(1, 0), cA + kstep, voffA); PG8_STAGE(PG8_SB(1, 1), cB + hstepB + kstep, voffB);
    PG8_WAIT_V(6); PG8_BAR;
    for (;;) {
        const bool has_next = unit_at(g, u0 + (ui + 1) * G, nxt);
        const char* nA = has_next ? (const char*)(g.A + (size_t)nxt.b * g.sA) + (size_t)nxt.pm * 2 * hstepA : cA;
        const char* nB = has_next ? (const char*)(g.B + (size_t)nxt.b * g.sB) + (size_t)nxt.pn * 2 * hstepB : cB;
        for (int t = 0; t < nt; t += 2) {
            const bool last = (t == nt - 2);
            const char* a1 = cA + (size_t)(t + 1) * kstep;
            const char* a2 = last ? nA : cA + (size_t)(t + 2) * kstep; const char* b2 = last ? nB : cB + (size_t)(t + 2) * kstep;
            const char* a3 = a2 + kstep; const char* b3 = b2 + kstep;
            PG8_LDB(B0, 0, 0); PG8_SCHED; PG8_LDA(At, 0, 0); PG8_STAGE(PG8_SA(1, 1), a1 + hstepA, voffA);
            PG8_WAIT_L(8); PG8_BAR; PG8_WAIT_L(0); PG8_MMA(0, 0, At, B0); PG8_BAR; PG8_SCHED;
            PG8_LDB(B1, 0, 1); PG8_STAGE(PG8_SB(0, 0), b2, voffB);
            PG8_BAR; PG8_WAIT_L(0); PG8_MMA(0, 1, At, B1); PG8_BAR;
            PG8_LDA(At, 0, 1); PG8_STAGE(PG8_SA(0, 0), a2, voffA);
            PG8_BAR; PG8_WAIT_L(0); PG8_MMA(1, 0, At, B0); PG8_BAR; PG8_SCHED;
            PG8_STAGE(PG8_SB(0, 1), b2 + hstepB, voffB);
            PG8_WAIT_V(6); PG8_BAR; PG8_MMA(1, 1, At, B1); PG8_BAR;
            PG8_LDB(B0, 1, 0); PG8_SCHED; PG8_LDA(At, 1, 0); PG8_STAGE(PG8_SA(0, 1), a2 + hstepA, voffA);
            PG8_WAIT_L(8); PG8_BAR; PG8_WAIT_L(0); PG8_MMA(0, 0, At, B0); PG8_BAR; PG8_SCHED;
            PG8_LDB(B1, 1, 1); PG8_STAGE(PG8_SB(1, 0), b3, voffB);
            PG8_BAR; PG8_WAIT_L(0); PG8_MMA(0, 1, At, B1); PG8_BAR;
            PG8_LDA(At, 1, 1); PG8_STAGE(PG8_SA(1, 0), a3, voffA);
            PG8_BAR; PG8_WAIT_L(0); PG8_MMA(1, 0, At, B0); PG8_BAR; PG8_SCHED;
            PG8_STAGE(PG8_SB(1, 1), b3 + hstepB, voffB);
            PG8_WAIT_V(6); PG8_BAR; PG8_MMA(1, 1, At, B1); PG8_BAR;
        }
        if constexpr (!Epi::AFTER_DRAIN) E(acc, cur, wr, wc, fr, fq);
        if (!has_next) break;
#pragma unroll
        for (int a = 0; a < 2; ++a)
#pragma unroll
            for (int b = 0; b < 2; ++b)
#pragma unroll
                for (int m = 0; m < 4; ++m)
#pragma unroll
                    for (int n = 0; n < 2; ++n) acc[a][b][m][n] = (f32x4){0.f, 0.f, 0.f, 0.f};
        cur = nxt; cA = nA; cB = nB; ++ui;
    }
    PG8_WAIT_V(0);
    if (wr == 0) PG8_BAR;
    PG8_BAR;
    if constexpr (Epi::AFTER_DRAIN) E.fused(acc, cur, wr, wc, fr, fq, lds, tid);
#undef PG8_SA
#undef PG8_SB
#undef PG8_STAGE
#undef PG8_LDA
#undef PG8_LDB
#undef PG8_MMA
#undef PG8_WAIT_V
#undef PG8_WAIT_L
#undef PG8_BAR
#undef PG8_SCHED
}

__device__ __forceinline__ void transpose_item(const float* W, int ldw, int Nsrc, bf16_t* WT, int ldt, int koff, LAS float* scrf, int item, int lane) {
    LAS unsigned* scr = (LAS unsigned*)scrf;
    const int nblk = Nsrc / 64, kb = item / nblk, nb = item % nblk, k0 = 64 * kb, n0 = 64 * nb, r = lane >> 4, cq = (lane & 15) * 4;
    { const float* src = W + (size_t)(k0 + r) * ldw + n0 + cq; f32x4 v[16];
#pragma unroll
      for (int i = 0; i < 16; ++i) v[i] = *(const f32x4*)(src + (size_t)(4 * i) * ldw);
#pragma unroll
      for (int i = 0; i < 16; ++i) { const int k = 4 * i + r; LAS unsigned* d2 = scr + k * 33 + (cq >> 1); d2[0] = pk2(v[i][0], v[i][1]); d2[1] = pk2(v[i][2], v[i][3]); } }
    LDS_WAIT();
    const int c8 = lane & 7, np = lane >> 3;
#pragma unroll
    for (int j = 0; j < 4; ++j) { const int n2 = j * 8 + np;
        unsigned w[8];
#pragma unroll
        for (int e = 0; e < 8; ++e) w[e] = scr[(c8 * 8 + e) * 33 + n2];
        u32x4 lo, hi;
        lo.x = (w[0] & 0xffffu) | (w[1] << 16); lo.y = (w[2] & 0xffffu) | (w[3] << 16); lo.z = (w[4] & 0xffffu) | (w[5] << 16); lo.w = (w[6] & 0xffffu) | (w[7] << 16);
        hi.x = (w[0] >> 16) | (w[1] & 0xffff0000u); hi.y = (w[2] >> 16) | (w[3] & 0xffff0000u); hi.z = (w[4] >> 16) | (w[5] & 0xffff0000u); hi.w = (w[6] >> 16) | (w[7] & 0xffff0000u);
        bf16_t* dst = WT + (size_t)(n0 + 2 * n2) * ldt + koff + k0 + 8 * c8;
        *(u32x4*)dst = lo; *(u32x4*)(dst + ldt) = hi; }
    LDS_WAIT();
}

template <int D>
__device__ __forceinline__ void fold_item(const float* coef, const float* scale, const float* W, int ldw, bf16_t* dst, LAS float* scr, int lane) {
    float acc[16];
#pragma unroll
    for (int i = 0; i < 16; ++i) acc[i] = 0.f;
#pragma unroll 1
    for (int dc = 0; dc < D; dc += 64) {
        float cr[16]; const float sc = scale ? scale[dc + lane] : 1.f;
#pragma unroll
        for (int i = 0; i < 16; ++i) cr[i] = coef[(size_t)i * D + dc + lane];
        { float v[64];
#pragma unroll
          for (int d = 0; d < 64; ++d) v[d] = W[(size_t)(dc + d) * ldw + lane];
#pragma unroll
          for (int d = 0; d < 64; ++d) scr[d * 64 + lane] = v[d]; }
#pragma unroll
        for (int i = 0; i < 16; ++i) cr[i] *= sc;
        LDS_WAIT();
#pragma unroll 8
        for (int d = 0; d < 64; ++d) { const float w = scr[d * 64 + lane];
#pragma unroll
            for (int i = 0; i < 16; ++i) acc[i] += __int_as_float(__builtin_amdgcn_readlane(__float_as_int(cr[i]), d)) * w; }
        LDS_WAIT();
    }
    u32x4 o0, o1; o0.x = pk2(acc[0], acc[1]); o0.y = pk2(acc[2], acc[3]); o0.z = pk2(acc[4], acc[5]); o0.w = pk2(acc[6], acc[7]);
    o1.x = pk2(acc[8], acc[9]); o1.y = pk2(acc[10], acc[11]); o1.z = pk2(acc[12], acc[13]); o1.w = pk2(acc[14], acc[15]);
    *(u32x4*)dst = o0; *(u32x4*)(dst + 8) = o1;
}

__device__ __forceinline__ void row_pass0(const Params& p, float* X, bf16_t* HY, const float* mod_next, const float* g_pre, int gw, int nw, int lane) {
    for (int row0 = gw; row0 < NTOK; row0 += 4 * nw) {
        f32x4 x[4][4];
#pragma unroll
        for (int r = 0; r < 4; ++r) { const int row = row0 + r * nw; if (row >= NTOK) continue;
            const float* src = (row < NPR) ? (p.in[0] + (size_t)row * DM + 4 * lane) : (p.in[1] + (size_t)(row - NPR) * DM + 4 * lane);
#pragma unroll
            for (int j = 0; j < 4; ++j) x[r][j] = *(const f32x4*)(src + 256 * j); }
#pragma unroll
        for (int r = 0; r < 4; ++r) { const int row = row0 + r * nw; if (row >= NTOK) continue;
            const int cond = row < NPR ? 0 : 1 + ((row - NPR) >> 12);
            float* xr = X + (size_t)row * DM + 4 * lane;
            if (row >= NPR) { const int t = (row - NPR) & 4095; const float pr = (float)(t >> 6), pc = (float)(t & 63);
#pragma unroll
                for (int j = 0; j < 4; ++j)
#pragma unroll
                    for (int e = 0; e < 4; ++e) { const int i = 4 * lane + e; const float om = __builtin_amdgcn_exp2f(-(float)i * (13.287712379549449f / 256.f));
                        const float ang = ((j < 2) ? pr : pc) * om; float sn, cn; sincos_rev(ang * 0.15915494309189535f, sn, cn); x[r][j][e] += (j & 1) ? cn : sn; } }
            float ss = 0.f;
#pragma unroll
            for (int j = 0; j < 4; ++j) { *(f32x4*)(xr + 256 * j) = x[r][j]; ss += (x[r][j][0] * x[r][j][0] + x[r][j][1] * x[r][j][1]) + (x[r][j][2] * x[r][j][2] + x[r][j][3] * x[r][j][3]); }
            const float rstd = __builtin_amdgcn_rsqf(wave_sum(ss) * (1.f / DM) + EPS);
            const float* sh = mod_next + cond * 6144 + 4 * lane; const float* sc = sh + 1024;
            bf16_t* hr = HY + (size_t)row * DM + 4 * lane;
#pragma unroll
            for (int j = 0; j < 4; ++j) { const f32x4 gp = *(const f32x4*)(g_pre + 4 * lane + 256 * j); const f32x4 s1 = *(const f32x4*)(sc + 256 * j); const f32x4 s0 = *(const f32x4*)(sh + 256 * j);
                st_bf4(hr + 256 * j, x[r][j] * rstd * gp * (1.f + s1) + s0); }
        }
    }
}

constexpr int CI0 = 16 * 16  , CI1 = CI0 + 12 * 12  , CI2 = CI1 + 12 * 16  , CI3 = CI2 + 16 * 24  , CI4 = CI3 + 16 * 64  ,
              CI5 = CI4 + 64 * 16  , CI6 = CI5 + 8 * 16  ;
#define CONV_ITEMS(LO, HI, WIDX, NWV) do { for (int it_ = (LO) + (WIDX); it_ < (HI); it_ += (NWV)) { \
        if (it_ < CI0) transpose_item(p.in[14], 1024, 1024, WIN0, 1024, 0, scr, it_, lane); \
        else if (it_ < CI1) transpose_item(p.in[24], 768, 768, WGLU, 768, 0, scr, it_ - CI0, lane); \
        else if (it_ < CI2) transpose_item(p.in[15], 1024, 1024, WOUT0, 1280, 0, scr, it_ - CI1, lane); \
        else if (it_ < CI3) transpose_item(p.in[36], 1536, 1536, WIN1, 1024, 0, scr, it_ - CI2, lane); \
        else if (it_ < CI4) transpose_item(p.in[12], 4096, 4096, WFF1, 1024, 0, scr, it_ - CI3, lane); \
        else if (it_ < CI5) transpose_item(p.in[13], 1024, 1024, WFF2, 4096, 0, scr, it_ - CI4, lane); \
        else transpose_item(p.in[37] + (size_t)512 * 1024, 1024, 1024, WOUT1, 1024, 512, scr, it_ - CI5, lane); } } while (0)
#define FOLD_ITEMS(LO, HI, WIDX, NWV) do { for (int it_ = (LO) + (WIDX); it_ < (HI); it_ += (NWV)) { \
        if (it_ < 16) { const int n = it_ * 64 + lane; float sm = 0.f; \
            _Pragma("unroll 1") for (int jc = 0; jc < 256; jc += 64) { const float fb = p.in[27][jc + lane]; float v[64]; \
                _Pragma("unroll") for (int j = 0; j < 64; ++j) v[j] = p.in[15][(size_t)(768 + jc + j) * 1024 + n]; \
                _Pragma("unroll") for (int j = 0; j < 64; ++j) sm += __int_as_float(__builtin_amdgcn_readlane(__float_as_int(fb), j)) * v[j]; } \
            BIAS0[n] = sm; } \
        else { const int it = it_ - 16; const int nb = it & 15, cb = (it >> 4) & 7, g = it >> 7, n = nb * 64 + lane; \
            fold_item<128>(p.in[38] + (size_t)(g * 128 + cb * 16) * 128, p.in[39] + g * 128, p.in[37] + (size_t)(g * 128) * 1024 + nb * 64, 1024, WOUT1 + (size_t)n * 1024 + g * 128 + cb * 16, scr, lane); } } } while (0)

__global__ void __launch_bounds__(512, 2) mega_fwd(Params p) {
    extern __shared__ __attribute__((aligned(16))) unsigned char smem[];
    LAS unsigned char* lds = (LAS unsigned char*)smem;
    cg::grid_group grid = cg::this_grid();
    const int wv = __builtin_amdgcn_readfirstlane((int)(threadIdx.x >> 6));
    volatile LAS unsigned* xb_st = (volatile LAS unsigned*)(lds + 131072);
    unsigned* xb_bar = (unsigned*)(p.ws + WS_BAR);
    if (threadIdx.x == 0) { xb_st[0] = 0u; xb_st[1] = 0u; (void)xb_add(&xb_bar[XB_XCNT(xb_xcc_id())], 1u); }
    __syncthreads();
    if (p.ws == nullptr) grid.sync();
#define GSYNC() xcd_barrier((unsigned*)(p.ws + WS_BAR), (volatile LAS unsigned*)(lds + 131072), wv)
    const int G = gridDim.x, c = blockIdx.x, GT = G * 512, NW = G * 8;
#define PHASE_PTRS unsigned long long wz_ = 0; asm volatile("" : "+s"(wz_)); unsigned char* ws = p.ws + wz_; \
    float* X = p.out; \
    bf16_t* WFF1 = (bf16_t*)(ws + WS_WFF1); bf16_t* WFF2 = (bf16_t*)(ws + WS_WFF2); bf16_t* WIN0 = (bf16_t*)(ws + WS_WIN0); bf16_t* WGLU = (bf16_t*)(ws + WS_WGLU); \
    bf16_t* WOUT0 = (bf16_t*)(ws + WS_WOUT0); bf16_t* WIN1 = (bf16_t*)(ws + WS_WIN1); bf16_t* WOUT1 = (bf16_t*)(ws + WS_WOUT1); \
    bf16_t* ME = (bf16_t*)(ws + WS_ME); bf16_t* SG = (bf16_t*)(ws + WS_SG); bf16_t* D512 = (bf16_t*)(ws + WS_D512); bf16_t* A2 = (bf16_t*)(ws + WS_A2); \
    float* MOD = (float*)(ws + WS_MOD); f32x2* APOW = (f32x2*)(ws + WS_APOW); f32x2* BBT = (f32x2*)(ws + WS_BBT); float* KTAB = (float*)(ws + WS_KTAB); \
    float* CSW = (float*)(ws + WS_CSW); float* BIAS0 = (float*)(ws + WS_BIAS0); \
    bf16_t* HY = (bf16_t*)(ws + WS_HY); bf16_t* MIX = (bf16_t*)(ws + WS_MIX); \
    bf16_t* UH = (bf16_t*)(ws + WS_UH); float* SLOC = (float*)(ws + WS_SLOC); bf16_t* GB = (bf16_t*)(ws + WS_G); \
    bf16_t* ZT = (bf16_t*)(ws + WS_ZT); bf16_t* YT = (bf16_t*)(ws + WS_YT); bf16_t* ZUV = (bf16_t*)(ws + WS_ZUV); bf16_t* VT = (bf16_t*)(ws + WS_VT); \
    bf16_t* HMID = (bf16_t*)(ws + WS_HMID);
#define PHASE_IDS PHASE_PTRS const int tid = tid_fresh(wv), lane = tid & 63, wave = __builtin_amdgcn_readfirstlane(tid >> 6), gtid = c * 512 + tid, gw = wave * G + c; \
    LAS float* scr = (LAS float*)(lds + wave * 16384); (void)lane; (void)gtid; (void)gw; (void)scr;
#pragma unroll 1
    for (int rep = 0; rep < REP_P0; ++rep) {
        PHASE_IDS
        for (int cgi = c; cgi < 192; cgi += G) {
            const int layer = cgi / 96, r96 = cgi % 96, strip = r96 % 12, ks = r96 / 12;
            LAS float* sl = (LAS float*)lds; LAS float* red = sl + 3072;
            for (int i = tid; i < 3072; i += 512) { const int cd = i >> 10, k = i & 1023; const float v = (cd == 0) ? PIN(5)[k] : PIN(4)[(cd - 1) * 1024 + k]; sl[i] = v * sigm(v); }
            __syncthreads();
            const float* Wm = PIN(layer ? 28 : 6) + (size_t)(ks * 128 + wave * 16) * 6144 + strip * 512 + lane * 4;
            f32x4 a0 = {0.f, 0.f, 0.f, 0.f}, a1 = a0, a2 = a0, b0 = a0, b1 = a0, b2 = a0;
#pragma unroll
            for (int i = 0; i < 16; ++i) { const int k = ks * 128 + wave * 16 + i; const f32x4 w0 = *(const f32x4*)(Wm + (size_t)i * 6144), w1 = *(const f32x4*)(Wm + (size_t)i * 6144 + 256);
                const float s0 = sl[k], s1 = sl[1024 + k], s2 = sl[2048 + k]; a0 += s0 * w0; a1 += s1 * w0; a2 += s2 * w0; b0 += s0 * w1; b1 += s1 * w1; b2 += s2 * w1; }
            { LAS float* r = red + wave * 1536 + lane * 4; *(LAS f32x4*)r = a0; *(LAS f32x4*)(r + 256) = b0; *(LAS f32x4*)(r + 512) = a1; *(LAS f32x4*)(r + 768) = b1; *(LAS f32x4*)(r + 1024) = a2; *(LAS f32x4*)(r + 1280) = b2; }
            __syncthreads();
            for (int o = tid; o < 1536; o += 512) { const int cd = o >> 9, col = o & 511; float sm = (ks == 0) ? PIN(layer ? 29 : 7)[strip * 512 + col] : 0.f;
#pragma unroll
                for (int w = 0; w < 8; ++w) sm += red[w * 1536 + o];
                atomicAdd(MOD + (layer * 3 + cd) * 6144 + strip * 512 + col, sm); }
            __syncthreads();
        }
        const int hb = c - 204, nhb = G - 204;
        if (hb >= 0) CONV_ITEMS(0, CI1, hb * 8 + wave, nhb * 8);
        if (hb >= 0) for (int idx = hb * 512 + tid; idx < 32768; idx += nhb * 512) {
            const int d = idx & 63, cc = (idx >> 6) & 63, cs = (idx >> 12) & 1, g = idx >> 13; float sm = 0.f;
            const float* fw = PIN(26) + (size_t)(g * 64) * 64 + d;
#pragma unroll
            for (int m0 = 0; m0 < 64; m0 += 16) { float w[16];
#pragma unroll
                for (int k = 0; k < 16; ++k) w[k] = fw[(m0 + k) * 64];
#pragma unroll
                for (int k = 0; k < 16; ++k) { float sn, cn; sincos_rev((float)(((m0 + k) * cc) & 63) * (1.f / 64.f), sn, cn); sm += (cs ? sn : cn) * w[k]; } }
            CSW[idx] = sm;
        }
        for (int idx = gtid; idx < 131072; idx += GT) {
            const int kk = idx & 127, hp = (idx >> 7) & 1, q = (idx >> 8) & 127, h = (idx >> 15) & 1, pair = idx >> 16;
            A2[idx] = (h == hp) ? f2bf(PIN(42)[((pair * 2 + h) * 128 + q) * 128 + kk]) : (bf16_t)0;
        }
        for (int idx = gtid; idx < 262144; idx += GT) {
            const int l2 = idx & 255, csp = (idx >> 8) & 1, k2 = (idx >> 9) & 255, cs = idx >> 17; float sn, cn; sincos_rev((float)((k2 * l2) & 255) * (1.f / 256.f), sn, cn);
            D512[idx] = f2bf(cs == csp ? cn : (cs ? -sn : sn));
        }
        if (c >= 192) for (int idx = (c - 192) * 512 + tid; idx < 6144 * 33; idx += (G - 192) * 512) {
            const int e = idx / 6144, q = idx - e * 6144, pp = q & 63, dir = (q >> 6) & 1, g = q >> 7; const int li = (dir * 48 + g) * 64 + pp;
            const float lr = PIN(16)[li], lim = PIN(17)[li], dt = fexp(PIN(18)[dir * 48 + g]);
            if (e < 17) { const float mag = fexp(lr * dt * (float)e); float sn, cn; sincos_rev(lim * dt * (float)e * 0.15915494309189535f, sn, cn); APOW[((g * 2 + dir) * 17 + e) * 64 + pp] = (f32x2){mag * cn, mag * sn}; }
            else { const int h = e - 17; const float mag = fexp(lr * dt); float sn, cn; sincos_rev(lim * dt * 0.15915494309189535f, sn, cn);
                const float nr = mag * cn - 1.f, ni = mag * sn, den = lr * lr + lim * lim;
                const float cr = (nr * lr + ni * lim) / den, ci = (ni * lr - nr * lim) / den;
                const float br = PIN(19)[(size_t)li * 16 + h], bi = PIN(20)[(size_t)li * 16 + h]; BBT[((g * 2 + dir) * 64 + pp) * 16 + h] = (f32x2){cr * br - ci * bi, cr * bi + ci * br}; }
        }
        if (rep + 1 < REP_P0) GSYNC();
    }
    GSYNC();
#pragma unroll 1
    for (int es = 0; es < EXTRA_SYNC; ++es) GSYNC();

#pragma unroll 1
    for (int rep = 0; rep < REP_P1; ++rep) {
        PHASE_IDS
        row_pass0(p, X, HY, MOD, PIN(8), gw, NW, lane);
        if (c >= 192) FOLD_ITEMS(0, 16, (G - 192) * 8 - 1 - ((c - 192) * 8 + wave), (G - 192) * 8);
        if (c >= 192) for (int it = (c - 192) * 8 + wave; it < 512; it += (G - 192) * 8) {
            const int nb = it & 15, jb = it >> 4, g = jb >> 3, n = nb * 64 + lane;
            fold_item<64>(CSW + (size_t)(jb * 16) * 64, nullptr, PIN(15) + (size_t)(768 + g * 64) * 1024 + nb * 64, 1024, WOUT0 + (size_t)n * 1280 + 768 + jb * 16, scr, lane);
        }
        for (int idx = gtid; idx < 98304; idx += GT) {
            const int hq = idx & 3, h = (idx >> 2) & 15, j = (idx >> 6) & 15, dir = (idx >> 10) & 1, g = idx >> 11; f32x4 sm = {0.f, 0.f, 0.f, 0.f};
            const float* cre = PIN(21) + ((size_t)(dir * 48 + g) * 16 + h) * 64; const float* cim = PIN(22) + ((size_t)(dir * 48 + g) * 16 + h) * 64;
            const f32x2* ap = APOW + ((g * 2 + dir) * 17 + j) * 64; const f32x4* bb = (const f32x4*)(BBT + (size_t)((g * 2 + dir) * 64) * 16 + hq * 4);
#pragma unroll 8
            for (int pp = 0; pp < 64; ++pp) { const f32x2 a = ap[pp]; const float cr = cre[pp], ci = cim[pp]; const float er = cr * a.x - ci * a.y, ei = cr * a.y + ci * a.x;
                const f32x4 b0 = bb[pp * 8], b1 = bb[pp * 8 + 1];
                sm[0] += er * b0[0] - ei * b0[1]; sm[1] += er * b0[2] - ei * b0[3]; sm[2] += er * b1[0] - ei * b1[1]; sm[3] += er * b1[2] - ei * b1[3]; }
            *(f32x4*)(KTAB + (size_t)idx * 4) = sm;
        }
#pragma unroll 3
        for (int idx = gtid; idx < 48 * 8192; idx += GT) {
            const int p8 = (idx & 7) * 8, ri = (idx >> 3) & 1, dir = (idx >> 4) & 1, h = (idx >> 5) & 15, tau = (idx >> 9) & 15, g = idx >> 13;
            const int e = dir ? (16 - tau) : (tau + 1); const f32x4* ap = (const f32x4*)(APOW + ((g * 2 + dir) * 17 + e) * 64 + p8);
            const size_t ci = ((size_t)(dir * 48 + g) * 16 + h) * 64 + p8; const f32x4* crp = (const f32x4*)(PIN(21) + ci); const f32x4* cip = (const f32x4*)(PIN(22) + ci);
            const f32x4 a0 = ap[0], a1 = ap[1], a2 = ap[2], a3 = ap[3], cr0 = crp[0], cr1 = crp[1], ci0 = cip[0], ci1 = cip[1];
            float o[8];
            if (ri) { o[0] = -(cr0[0] * a0[1] + ci0[0] * a0[0]); o[1] = -(cr0[1] * a0[3] + ci0[1] * a0[2]); o[2] = -(cr0[2] * a1[1] + ci0[2] * a1[0]); o[3] = -(cr0[3] * a1[3] + ci0[3] * a1[2]);
                      o[4] = -(cr1[0] * a2[1] + ci1[0] * a2[0]); o[5] = -(cr1[1] * a2[3] + ci1[1] * a2[2]); o[6] = -(cr1[2] * a3[1] + ci1[2] * a3[0]); o[7] = -(cr1[3] * a3[3] + ci1[3] * a3[2]); }
            else    { o[0] = cr0[0] * a0[0] - ci0[0] * a0[1]; o[1] = cr0[1] * a0[2] - ci0[1] * a0[3]; o[2] = cr0[2] * a1[0] - ci0[2] * a1[1]; o[3] = cr0[3] * a1[2] - ci0[3] * a1[3];
                      o[4] = cr1[0] * a2[0] - ci1[0] * a2[1]; o[5] = cr1[1] * a2[2] - ci1[1] * a2[3]; o[6] = cr1[2] * a3[0] - ci1[2] * a3[1]; o[7] = cr1[3] * a3[2] - ci1[3] * a3[3]; }
            u32x4 w; w.x = pk2(o[0], o[1]); w.y = pk2(o[2], o[3]); w.z = pk2(o[4], o[5]); w.w = pk2(o[6], o[7]);
            *(u32x4*)(ME + ((size_t)g * 256 + tau * 16 + h) * 512 + 256 + dir * 128 + ri * 64 + p8) = w;
        }
#pragma unroll 3
        for (int idx = gtid; idx < 48 * 8192; idx += GT) {
            const int h8 = (idx & 1) * 8, sq = (idx >> 1) & 15, pp = (idx >> 5) & 63, ri = (idx >> 11) & 1, dir = (idx >> 12) & 1, g = idx >> 13;
            const int e = dir ? sq : (15 - sq); const f32x2 a = APOW[((g * 2 + dir) * 17 + e) * 64 + pp]; const f32x4* bp = (const f32x4*)(BBT + ((g * 2 + dir) * 64 + pp) * 16 + h8);
            const f32x4 b0 = bp[0], b1 = bp[1], b2 = bp[2], b3 = bp[3];
            float o[8];
            if (ri) { o[0] = a.x * b0[1] + a.y * b0[0]; o[1] = a.x * b0[3] + a.y * b0[2]; o[2] = a.x * b1[1] + a.y * b1[0]; o[3] = a.x * b1[3] + a.y * b1[2];
                      o[4] = a.x * b2[1] + a.y * b2[0]; o[5] = a.x * b2[3] + a.y * b2[2]; o[6] = a.x * b3[1] + a.y * b3[0]; o[7] = a.x * b3[3] + a.y * b3[2]; }
            else    { o[0] = a.x * b0[0] - a.y * b0[1]; o[1] = a.x * b0[2] - a.y * b0[3]; o[2] = a.x * b1[0] - a.y * b1[1]; o[3] = a.x * b1[2] - a.y * b1[3];
                      o[4] = a.x * b2[0] - a.y * b2[1]; o[5] = a.x * b2[2] - a.y * b2[3]; o[6] = a.x * b3[0] - a.y * b3[1]; o[7] = a.x * b3[2] - a.y * b3[3]; }
            u32x4 w; w.x = pk2(o[0], o[1]); w.y = pk2(o[2], o[3]); w.z = pk2(o[4], o[5]); w.w = pk2(o[6], o[7]);
            *(u32x4*)(SG + (size_t)idx * 8) = w;
        }
        if (rep + 1 < REP_P1) GSYNC();
    }
    GSYNC();

    {
        PHASE_IDS
#pragma unroll 3
        for (int idx = gtid; idx < 48 * 8192; idx += GT) {
            const int h8 = (idx & 1) * 8, sq = (idx >> 1) & 15, h = (idx >> 5) & 15, tau = (idx >> 9) & 15, g = idx >> 13;
            f32x4 v0 = {0.f, 0.f, 0.f, 0.f}, v1 = v0;
            if (sq <= tau) { const f32x4* k = (const f32x4*)(KTAB + (((g * 2 + 0) * 16 + (tau - sq)) * 16 + h) * 16 + h8); v0 += k[0]; v1 += k[1]; }
            if (sq >= tau) { const f32x4* k = (const f32x4*)(KTAB + (((g * 2 + 1) * 16 + (sq - tau)) * 16 + h) * 16 + h8); v0 += k[0]; v1 += k[1]; }
            if (sq == tau && (h >> 3) == (h8 >> 3)) { const float dv = p.in[23][g * 16 + h]; const int hl = h & 7;
                if (hl < 4) v0[hl] += dv; else v1[hl - 4] += dv; }
            u32x4 w; w.x = pk2(v0[0], v0[1]); w.y = pk2(v0[2], v0[3]); w.z = pk2(v1[0], v1[1]); w.w = pk2(v1[2], v1[3]);
            *(u32x4*)(ME + ((size_t)g * 256 + tau * 16 + h) * 512 + sq * 16 + h8) = w;
        }
    }
    {
        PHASE_IDS
        GJob<1024, 1024, 1024, 64, 3, 1, 0, 0> ja{HY, WIN0};
        gemm_phase(lds, ja, 0, c, G, EpiU{UH}, wv);
        GJob<1024, 1024, 1024, 1, 64, 1, 0, 0> jb{WIN0 + (size_t)768 * 1024, HY};
        gemm_phase(lds, jb, 192, c, G, EpiZt{ZT}, wv);
    }
    GSYNC();

    {
        PHASE_IDS
        for (int idx = gtid; idx < 131072; idx += GT) {
            const int l2 = idx & 255, ch = (idx >> 8) & 255, b = idx >> 16;
            const bf16_t* z = ZT + (size_t)32 * 65536 + (size_t)b * (256 * 4096) + (size_t)ch * 4096 + l2;
            float xv[16];
#pragma unroll
            for (int l1 = 0; l1 < 16; ++l1) xv[l1] = bf2f(z[256 * l1]);
            constexpr float C16[16] = {1.f, 0.92387953251f, 0.70710678119f, 0.38268343237f, 0.f, -0.38268343237f, -0.70710678119f, -0.92387953251f, -1.f, -0.92387953251f, -0.70710678119f, -0.38268343237f, 0.f, 0.38268343237f, 0.70710678119f, 0.92387953251f};
            constexpr float S16[16] = {0.f, 0.38268343237f, 0.70710678119f, 0.92387953251f, 1.f, 0.92387953251f, 0.70710678119f, 0.38268343237f, 0.f, -0.38268343237f, -0.70710678119f, -0.92387953251f, -1.f, -0.92387953251f, -0.70710678119f, -0.38268343237f};
#pragma unroll
            for (int k1 = 0; k1 < 16; ++k1) {
                float yr = 0.f, yi = 0.f;
#pragma unroll
                for (int l1 = 0; l1 < 16; ++l1) { yr += xv[l1] * C16[(l1 * k1) & 15]; yi -= xv[l1] * S16[(l1 * k1) & 15]; }
                float sn, cn; sincos_rev((float)(l2 * k1) * (1.f / 4096.f), sn, cn);
                bf16_t* o = YT + ((size_t)((b * 16 + k1) * 256 + ch)) * 512 + l2;
                o[0] = f2bf(yr * cn + yi * sn); o[256] = f2bf(yi * cn - yr * sn);
            }
        }
        if (c >= 192) CONV_ITEMS(CI1, CI6, (c - 192) * 8 + wave, (G - 192) * 8);
    }
    {
        PHASE_IDS
        GJob<512, 256, 256, 4, 1, 48, 1024 * 512, 256 * 256> js{UH, SG};
        gemm_phase(lds, js, 0, c, G, EpiState{SLOC}, wv);
    }
    {
        PHASE_IDS
        GJob<512, 256, 256, 4, 1, 48, 1024 * 512, 256 * 256> js{UH, SG};
        if (c < 192) {
            asm volatile("s_waitcnt vmcnt(0)" ::: "memory"); __syncthreads();
            Unit un; unit_at(js, c, un); const int g = un.b, pp = lane;
#define SCAN_SHORT4(DIRC) { const f32x2 a16 = APOW[((g * 2 + DIRC) * 17 + 16) * 64 + pp]; float sr[4][16], si[4][16]; \
                    _Pragma("unroll") for (int i = 0; i < 4; ++i) { const int seq = un.pm * 16 + (wave >> 1) + 4 * i; const float* __restrict__ S = SLOC + ((size_t)g * 1024 + seq * 16) * 256 + DIRC * 128 + pp; \
                        _Pragma("unroll") for (int k = 0; k < 16; ++k) { const int cc = DIRC ? (15 - k) : k; sr[i][k] = S[(size_t)cc * 256]; si[i][k] = S[(size_t)cc * 256 + 64]; } } \
                    _Pragma("unroll") for (int i = 0; i < 4; ++i) { const int seq = un.pm * 16 + (wave >> 1) + 4 * i; bf16_t* __restrict__ Hn = UH + ((size_t)g * 1024 + seq * 16) * 512 + 256 + DIRC * 128 + pp; \
                        float hr = 0.f, hi = 0.f; \
                        _Pragma("unroll") for (int k = 0; k < 16; ++k) { const int cc = DIRC ? (15 - k) : k; Hn[(size_t)cc * 512] = f2bf(hr); Hn[(size_t)cc * 512 + 64] = f2bf(hi); \
                            const float nr = a16.x * hr - a16.y * hi + sr[i][k], ni = a16.x * hi + a16.y * hr + si[i][k]; hr = nr; hi = ni; } \
                        const int oi = ((seq * 2 + DIRC) * 48 + g) * 64 + pp; p.out[(size_t)2 * NPR * DM + oi] = hr; p.out[(size_t)2 * NPR * DM + 196608 + oi] = hi; } }
#define SCAN_LONG(DIRC) { const f32x2 a16 = APOW[((g * 2 + DIRC) * 17 + 16) * 64 + pp]; f32x2 a64 = a16; \
                    _Pragma("unroll") for (int q = 0; q < 6; ++q) a64 = (f32x2){a64.x * a64.x - a64.y * a64.y, 2.f * a64.x * a64.y}; \
                    const float* __restrict__ S = SLOC + ((size_t)g * 1024 + row0 + (DIRC ? (255 - sg * 64) : sg * 64)) * 256 + DIRC * 128 + pp; \
                    bf16_t* __restrict__ Hn = UH + ((size_t)g * 1024 + row0 + (DIRC ? (255 - sg * 64) : sg * 64)) * 512 + 256 + DIRC * 128 + pp; \
                    float sr[64], si[64]; \
                    _Pragma("unroll") for (int k = 0; k < 64; ++k) { const int cc = DIRC ? -k : k; sr[k] = S[cc * 256]; si[k] = S[cc * 256 + 64]; } \
                    float er = 0.f, ei = 0.f; \
                    _Pragma("unroll") for (int k = 0; k < 64; ++k) { const float nr = a16.x * er - a16.y * ei + sr[k], ni = a16.x * ei + a16.y * er + si[k]; er = nr; ei = ni; } \
                    Eb[(wave * 64 + lane) * 2] = er; Eb[(wave * 64 + lane) * 2 + 1] = ei; \
                    __syncthreads(); \
                    const int sidx0 = ((b * 2 + DIRC) * 48 + g) * 64 + pp; float hr = p.in[2][sidx0], hi = p.in[3][sidx0]; \
                    for (int j = 0; j < sg; ++j) { const float e0 = Eb[((DIRC * 4 + j) * 64 + lane) * 2], e1 = Eb[((DIRC * 4 + j) * 64 + lane) * 2 + 1]; \
                        const float nr = a64.x * hr - a64.y * hi + e0, ni = a64.x * hi + a64.y * hr + e1; hr = nr; hi = ni; } \
                    _Pragma("unroll") for (int k = 0; k < 64; ++k) { const int cc = DIRC ? -k : k; Hn[cc * 512] = f2bf(hr); Hn[cc * 512 + 64] = f2bf(hi); \
                        const float nr = a16.x * hr - a16.y * hi + sr[k], ni = a16.x * hi + a16.y * hr + si[k]; hr = nr; hi = ni; } \
                    __syncthreads(); }
            if (un.pm < 2) {
                if (wave & 1) SCAN_SHORT4(1) else SCAN_SHORT4(0)
            } else {
                const int b = un.pm - 2, sg = wave & 3, row0 = 512 + b * 256; LAS float* Eb = (LAS float*)lds;
                if (wave >> 2) SCAN_LONG(1) else SCAN_LONG(0)
            }
#undef SCAN_SHORT4
#undef SCAN_LONG
            asm volatile("s_waitcnt vmcnt(0)" ::: "memory"); __syncthreads();
        }
    }
    {
        PHASE_IDS
        GJob<512, 512, 512, 4, 1, 48, 1024 * 512, 256 * 512> jy{UH, ME};
        gemm_phase(lds, jy, 0, c, G, EpiY{GB}, wv);
    }
    GSYNC();

    {
        PHASE_IDS
        GJob<768, 768, 768, 64, 3, 1, 0, 0> jg{GB, WGLU};
        gemm_phase(lds, jg, 0, c, G, EpiGlu{GB, p.in[25], MIX}, wv);
        if (c >= 192) {
            GJob<512, 256, 256, 2, 1, 32, 0, 65536> jp{D512, ZT};
            gemm_phase(lds, jp, 0, c - 192, 64, EpiDft{MIX, 0, 1.f / 128.f}, wv);
            GJob<512, 512, 512, 2, 1, 32, 0, 256 * 512> jsm{D512, YT};
            gemm_phase(lds, jsm, 64, c - 192, 64, EpiDft{MIX, 1, 1.f / 512.f}, wv);
        }
    }
    {
        PHASE_IDS
        (void)0;
    }
    GSYNC();

    {
        PHASE_IDS
        GJob<1280, 1280, 1280, 64, 4, 1, 0, 0> jo{MIX, WOUT0};
        RowStat s1{(float*)(ws + WS_SLOT), (unsigned*)(ws + WS_CNT) + 0 * 1024}, s2{(float*)(ws + WS_SLOT) + 65536, (unsigned*)(ws + WS_CNT) + 1 * 1024};
        gemm_phase(lds, jo, 0, c, G, EpiResNorm{X, HY, BIAS0, MOD, 2048, p.in[9], MOD, 3072, p.in[10], s1, s2, 1}, wv);
    }
    GSYNC();

#pragma unroll 1
    for (int rep = 0; rep < REP_FF1; ++rep) {
        PHASE_IDS
        GJob<1024, 1024, 1024, 64, 16, 1, 0, 0> j1{HY, WFF1};
        gemm_phase(lds, j1, 0, c, G, EpiRelu2{HMID}, wv);
        GSYNC();
    }
    {
        PHASE_IDS
        GJob<4096, 4096, 4096, 64, 4, 1, 0, 0> j2{HMID, WFF2};
        RowStat s1{(float*)(ws + WS_SLOT), (unsigned*)(ws + WS_CNT) + 2 * 1024}, s2{(float*)(ws + WS_SLOT) + 65536, (unsigned*)(ws + WS_CNT) + 3 * 1024};
        gemm_phase(lds, j2, 0, c, G, EpiResNorm{X, HY, nullptr, MOD, 5120, p.in[11], MOD + 3 * 6144, 0, p.in[30], s1, s2, 1}, wv);
    }
    GSYNC();

    {
        PHASE_IDS
        GJob<1024, 1024, 1024, 64, 6, 1, 0, 0> ji{HY, WIN1};
        gemm_phase(lds, ji, 0, c, G, EpiPlain{ZUV, 1536, nullptr, 512}, wv);
    }
    {
        PHASE_IDS
        if (c >= 384 - G) {
            constexpr int I3 = 16 * 64, I4 = 64 * 16; const int nb1 = 2 * G - 384;
            FOLD_ITEMS(16, 528, nb1 * 8 - 1 - ((c - (384 - G)) * 8 + wave), nb1 * 8);
            for (int it = (c - (384 - G)) * 8 + wave; it < I3 + I4; it += nb1 * 8) {
                if (it < I3) transpose_item(p.in[34], 4096, 4096, WFF1, 1024, 0, scr, it, lane);
                else transpose_item(p.in[35], 1024, 1024, WFF2, 4096, 0, scr, it - I3, lane);
            }
        }
    }
    GSYNC();

    {
        PHASE_IDS
        GJob<256, 256, 256, 1, 64, 2, 256 * 256, 16384 * 256> jm{A2, VT};
        if (c < 128) {
            Unit un; unit_at(jm, c, un);
            LAS bf16_t* T = (LAS bf16_t*)lds;
#pragma unroll 1
            for (int r = 0; r < 2; ++r) {
                const int chunk = 2 * un.pn + r;
                const int sub = lane >> 4, q8 = (lane & 15) * 8;
                f32x4 gA[2], gB[2], bA[2], bB[2];
#pragma unroll
                for (int hh = 0; hh < 2; ++hh) { const int h = un.b * 2 + hh; gA[hh] = *(const f32x4*)(p.in[40] + h * 128 + q8); gB[hh] = *(const f32x4*)(p.in[40] + h * 128 + q8 + 4);
                    bA[hh] = *(const f32x4*)(p.in[41] + h * 128 + q8); bB[hh] = *(const f32x4*)(p.in[41] + h * 128 + q8 + 4); }
                u32x4 rv[8];
#pragma unroll
                for (int i = 0; i < 8; ++i) { const int R = i * 32 + wave * 4 + sub, hh = i >> 2, tok = R & 127;
                    rv[i] = *(const u32x4*)(ZUV + (size_t)(chunk * 128 + tok) * 1536 + 1024 + (un.b * 2 + hh) * 128 + q8); }
#pragma unroll
                for (int i = 0; i < 8; ++i) { const int R = i * 32 + wave * 4 + sub, hh = i >> 2, tok = R & 127;
                    float x[8] = {bflo(rv[i].x), bfhi(rv[i].x), bflo(rv[i].y), bfhi(rv[i].y), bflo(rv[i].z), bfhi(rv[i].z), bflo(rv[i].w), bfhi(rv[i].w)};
                    float sm = ((x[0] + x[1]) + (x[2] + x[3])) + ((x[4] + x[5]) + (x[6] + x[7]));
                    sm += __int_as_float(__builtin_amdgcn_ds_swizzle(__float_as_int(sm), 0x041f)); sm += __int_as_float(__builtin_amdgcn_ds_swizzle(__float_as_int(sm), 0x081f));
                    sm += __int_as_float(__builtin_amdgcn_ds_swizzle(__float_as_int(sm), 0x101f)); sm += __int_as_float(__builtin_amdgcn_ds_swizzle(__float_as_int(sm), 0x201f));
                    const float mu = sm * (1.f / 128.f); float sq = 0.f;
#pragma unroll
                    for (int e = 0; e < 8; ++e) { x[e] -= mu; sq += x[e] * x[e]; }
                    sq += __int_as_float(__builtin_amdgcn_ds_swizzle(__float_as_int(sq), 0x041f)); sq += __int_as_float(__builtin_amdgcn_ds_swizzle(__float_as_int(sq), 0x081f));
                    sq += __int_as_float(__builtin_amdgcn_ds_swizzle(__float_as_int(sq), 0x101f)); sq += __int_as_float(__builtin_amdgcn_ds_swizzle(__float_as_int(sq), 0x201f));
                    const float rstd = __builtin_amdgcn_rsqf(sq * (1.f / 128.f) + EPS);
                    const f32x4 ga = gA[hh], gb = gB[hh], ba = bA[hh], bb = bB[hh];
                    u32x4 w4; w4.x = pk2(x[0] * rstd * ga[0] + ba[0], x[1] * rstd * ga[1] + ba[1]); w4.y = pk2(x[2] * rstd * ga[2] + ba[2], x[3] * rstd * ga[3] + ba[3]);
                    w4.z = pk2(x[4] * rstd * gb[0] + bb[0], x[5] * rstd * gb[1] + bb[1]); w4.w = pk2(x[6] * rstd * gb[2] + bb[2], x[7] * rstd * gb[3] + bb[3]);
                    *(LAS u32x4*)(T + (hh * 128 + tok) * 136 + q8) = w4; }
                __syncthreads();
                { const int hh = tid >> 8, seg = (tid >> 7) & 1, d = tid & 127; const LAS bf16_t* sp = T + (hh * 128 + seg * 64) * 136 + d;
                  bf16_t* dst = VT + (size_t)un.b * ((size_t)16384 * 256) + (size_t)(chunk * 128 + d) * 256 + hh * 128 + seg * 64;
#pragma unroll
                  for (int q = 0; q < 8; ++q) { u32x4 o;
                      o.x = (unsigned)sp[(q * 8 + 0) * 136] | ((unsigned)sp[(q * 8 + 1) * 136] << 16); o.y = (unsigned)sp[(q * 8 + 2) * 136] | ((unsigned)sp[(q * 8 + 3) * 136] << 16);
                      o.z = (unsigned)sp[(q * 8 + 4) * 136] | ((unsigned)sp[(q * 8 + 5) * 136] << 16); o.w = (unsigned)sp[(q * 8 + 6) * 136] | ((unsigned)sp[(q * 8 + 7) * 136] << 16);
                      *(u32x4*)(dst + q * 8) = o; } }
                __syncthreads();
            }
            asm volatile("s_waitcnt vmcnt(0)" ::: "memory");
            __syncthreads();
        } else {
            LAS bf16_t* R = (LAS bf16_t*)lds;
            for (int tile = c - 128; tile < 256; tile += 128) {
                const int token0 = tile * 64; int base, L; if (token0 < NPR) { base = token0 & ~255; L = 256; } else { base = NPR + ((token0 - NPR) & ~4095); L = 4096; }
                const int t0 = token0 - base;
                { u32x4 rv[10];
#pragma unroll
                  for (int k = 0; k < 10; ++k) { const int r = wave * 10 + k, t = t0 - 8 + r; rv[k] = (u32x4){0u, 0u, 0u, 0u};
                      if (t >= 0 && t < L) rv[k] = *(const u32x4*)(ZUV + (size_t)(base + t) * 1536 + lane * 8); }
#pragma unroll
                  for (int k = 0; k < 10; ++k) *(LAS u32x4*)(R + (wave * 10 + k) * 512 + lane * 8) = rv[k]; }
                __syncthreads();
                { const int hs = tid >> 8, cp = tid & 255, half = 1 << (cp >> 6); const LAS unsigned* Rc = (const LAS unsigned*)R + cp;
                  float s0 = 0.f, s1 = 0.f; const int i0 = hs * 32;
                  for (int r = i0 + 8 - half; r < i0 + 8 + half; ++r) { const unsigned w = Rc[r * 256]; s0 += bflo(w); s1 += bfhi(w); }
                  bf16_t* dst = MIX + (size_t)(token0 + i0) * 1024 + 2 * cp;
#pragma unroll 4
                  for (int i = i0; i < i0 + 32; ++i) { const int t = t0 + i; const int lo = (t - half) > 0 ? (t - half) : 0, hi = (t + half) < L ? (t + half) : L;
                      const unsigned wc = Rc[(i + 8) * 256]; const float inv = __builtin_amdgcn_rcpf((float)(hi - lo));
                      *(unsigned*)(dst + (size_t)(i - i0) * 1024) = pk2(s0 * inv - bflo(wc), s1 * inv - bfhi(wc));
                      const unsigned wa = Rc[(i + 8 + half) * 256], ws_ = Rc[(i + 8 - half) * 256]; s0 += bflo(wa) - bflo(ws_); s1 += bfhi(wa) - bfhi(ws_); } }
                __syncthreads();
            }
        }
        gemm_phase(lds, jm, 0, c, G, EpiGmlp{ZUV, p.in[43], MIX}, wv);
    }
    GSYNC();

    {
        PHASE_IDS
        GJob<1024, 1024, 1024, 64, 4, 1, 0, 0> jo{MIX, WOUT1};
        RowStat s1{(float*)(ws + WS_SLOT), (unsigned*)(ws + WS_CNT) + 4 * 1024}, s2{(float*)(ws + WS_SLOT) + 65536, (unsigned*)(ws + WS_CNT) + 5 * 1024};
        gemm_phase(lds, jo, 0, c, G, EpiResNorm{X, HY, nullptr, MOD + 3 * 6144, 2048, p.in[31], MOD + 3 * 6144, 3072, p.in[32], s1, s2, 1}, wv);
    }
    GSYNC();
#pragma unroll 1
    for (int rep = 0; rep < REP_FF1; ++rep) {
        PHASE_IDS
        GJob<1024, 1024, 1024, 64, 16, 1, 0, 0> j1{HY, WFF1};
        gemm_phase(lds, j1, 0, c, G, EpiRelu2{HMID}, wv);
        GSYNC();
    }
    {
        PHASE_IDS
        GJob<4096, 4096, 4096, 64, 4, 1, 0, 0> j2{HMID, WFF2};
        RowStat s1{(float*)(ws + WS_SLOT), (unsigned*)(ws + WS_CNT) + 6 * 1024}, s2{(float*)(ws + WS_SLOT) + 65536, (unsigned*)(ws + WS_CNT) + 7 * 1024};
        gemm_phase(lds, j2, 0, c, G, EpiResNorm{X, HY, nullptr, MOD + 3 * 6144, 5120, p.in[33], nullptr, 0, nullptr, s1, s2, 0}, wv);
    }
}

extern "C" void kernel_launch(void* const* d_in, const int* in_sizes, int n_in, void* d_out, int out_size, void* d_ws, size_t ws_size, hipStream_t stream) {
    static int grid_blocks = 0;
    if (grid_blocks == 0) {
        if (n_in != 44 || ws_size < WS_END) { fprintf(stderr, "kernel_launch: expected 44 inputs and >= %zu bytes of workspace, got %d / %zu\n", (size_t)WS_END, n_in, ws_size); grid_blocks = -1; return; }
        int dev = 0, cus = 0, per_cu = 0;
        (void)hipGetDevice(&dev);
        (void)hipDeviceGetAttribute(&cus, hipDeviceAttributeMultiprocessorCount, dev);
        if (hipFuncSetAttribute((const void*)mega_fwd, hipFuncAttributeMaxDynamicSharedMemorySize, LDS_BYTES) != hipSuccess) { fprintf(stderr, "kernel_launch: hipFuncSetAttribute failed\n"); grid_blocks = -1; return; }
        (void)hipOccupancyMaxActiveBlocksPerMultiprocessor(&per_cu, (const void*)mega_fwd, 512, LDS_BYTES);
        if (per_cu < 1) { fprintf(stderr, "kernel_launch: occupancy query says %d blocks per CU\n", per_cu); per_cu = 1; }
        (void)hipGetLastError();
        grid_blocks = cus;
        if (grid_blocks != 256) { fprintf(stderr, "kernel_launch: built for a 256-CU device (the fused norm epilogues need exactly 256 workgroups), got %d CUs\n", cus); grid_blocks = -1; return; }
    }
    if (grid_blocks <= 0) return;
    if (hipMemsetAsync((char*)d_ws + WS_BAR, 0, WS_ZERO_BYTES, stream) != hipSuccess) { fprintf(stderr, "kernel_launch: memset of the barrier words failed\n"); return; }
    if (hipMemsetAsync((char*)d_ws + WS_MOD, 0, 147456, stream) != hipSuccess) { fprintf(stderr, "kernel_launch: memset of the modulation accumulators failed\n"); return; }
    Params p{};
    for (int i = 0; i < 44; ++i) p.in[i] = (const float*)d_in[i];
    p.out = (float*)d_out; p.ws = (unsigned char*)d_ws;
    void* args[] = {&p};
    hipError_t e = hipLaunchCooperativeKernel((const void*)mega_fwd, dim3(grid_blocks), dim3(512), args, LDS_BYTES, stream);
    if (e != hipSuccess) fprintf(stderr, "cooperative launch failed: %s (grid %d)\n", hipGetErrorString(e), grid_blocks);
}
```

```cpp
#include <hip/hip_runtime.h>
#include <hip/hip_cooperative_groups.h>
#include <cstdio>
namespace cg = cooperative_groups;
#define REP_P0 1
#define REP_P1 1
#define REP_FF1 1
#define REP_FF2 1
#define EXTRA_SYNC 0

#define LAS __attribute__((address_space(3)))
typedef unsigned short bf16_t;
typedef short bf16x8 __attribute__((ext_vector_type(8)));
typedef float f32x4 __attribute__((ext_vector_type(4)));
typedef float f32x2 __attribute__((ext_vector_type(2)));
typedef unsigned u32x4 __attribute__((ext_vector_type(4)));
typedef unsigned u32x2 __attribute__((ext_vector_type(2)));

constexpr int NTOK = 16384, DM = 1024, NPR = 8192, DFF = 4096;
constexpr float EPS = 1e-6f;
constexpr int LDS_BYTES = 131072 + 16;
constexpr size_t MiB = 1048576;
constexpr size_t WS_WFF1 = 0;
constexpr size_t WS_WFF2 = WS_WFF1 + 8 * MiB;
constexpr size_t WS_WIN0 = WS_WFF2 + 8 * MiB;
constexpr size_t WS_WGLU = WS_WIN0 + 2 * MiB;
constexpr size_t WS_WOUT0 = WS_WGLU + 1179648;
constexpr size_t WS_WIN1 = WS_WOUT0 + 2621440;
constexpr size_t WS_WOUT1 = WS_WIN1 + 3 * MiB;
constexpr size_t WS_ME = WS_WOUT1 + 2 * MiB;
constexpr size_t WS_SG = WS_ME + 12 * MiB;
constexpr size_t WS_D512 = WS_SG + 6 * MiB;
constexpr size_t WS_A2 = WS_D512 + 524288;
constexpr size_t WS_MOD = WS_A2 + 262144;
constexpr size_t WS_APOW = WS_MOD + 147456;
constexpr size_t WS_BBT = WS_APOW + 835584;
constexpr size_t WS_KTAB = WS_BBT + 786432;
constexpr size_t WS_CSW = WS_KTAB + 1572864;
constexpr size_t WS_BIAS0 = WS_CSW + 131072;
constexpr size_t WS_HY = WS_BIAS0 + 4096;
constexpr size_t WS_MIX = WS_HY + 32 * MiB;
constexpr size_t WS_BIG = WS_MIX + 40 * MiB;
constexpr size_t WS_UH = WS_BIG;
constexpr size_t WS_SLOC = WS_BIG + 48 * MiB;
constexpr size_t WS_G = WS_HY;
constexpr size_t WS_ZT = WS_BIG + 96 * MiB;
constexpr size_t WS_YT = WS_BIG + 104 * MiB;
constexpr size_t WS_ZUV = WS_BIG;
constexpr size_t WS_VT = WS_BIG + 48 * MiB;
constexpr size_t WS_HMID = WS_BIG;
constexpr size_t WS_BAR = WS_BIG + 128 * MiB;
constexpr size_t WS_CNT = WS_BAR + 16384;
constexpr size_t WS_SLOT = WS_CNT + 32768;
constexpr size_t WS_END = WS_SLOT + 2 * 262144;
constexpr size_t WS_ZERO_BYTES = 16384 + 32768;

struct Params { const float* in[44]; float* out; unsigned char* ws; };
#define PIN(k) ([&]() -> const float* { int k_ = (k); asm volatile("" : "+s"(k_)); return p.in[k_]; }())

__device__ __forceinline__ unsigned pk2(float lo, float hi) { unsigned r; asm("v_cvt_pk_bf16_f32 %0, %1, %2" : "=v"(r) : "v"(lo), "v"(hi)); return r; }
__device__ __forceinline__ bf16_t f2bf(float f) { return (bf16_t)(pk2(f, 0.f) & 0xffffu); }
__device__ __forceinline__ float bf2f(bf16_t b) { return __uint_as_float(((unsigned)b) << 16); }
__device__ __forceinline__ float bflo(unsigned w) { return __uint_as_float(w << 16); }
__device__ __forceinline__ float bfhi(unsigned w) { return __uint_as_float(w & 0xffff0000u); }
__device__ __forceinline__ float fexp(float x) { return __builtin_amdgcn_exp2f(x * 1.4426950408889634f); }
__device__ __forceinline__ float sigm(float x) { return __builtin_amdgcn_rcpf(1.f + fexp(-x)); }
__device__ __forceinline__ float gelu_t(float x) { const float u = 0.7978845608028654f * (x + 0.044715f * x * x * x); return x * sigm(2.f * u); }
__device__ __forceinline__ void sincos_rev(float rev, float& s, float& c) { const float f = rev - floorf(rev); s = __builtin_amdgcn_sinf(f); c = __builtin_amdgcn_cosf(f); }
__device__ __forceinline__ float wave_sum(float v) {
    v += __int_as_float(__builtin_amdgcn_ds_swizzle(__float_as_int(v), 0x041f));
    v += __int_as_float(__builtin_amdgcn_ds_swizzle(__float_as_int(v), 0x081f));
    v += __int_as_float(__builtin_amdgcn_ds_swizzle(__float_as_int(v), 0x101f));
    v += __int_as_float(__builtin_amdgcn_ds_swizzle(__float_as_int(v), 0x201f));
    v += __int_as_float(__builtin_amdgcn_ds_swizzle(__float_as_int(v), 0x401f));
    return __int_as_float(__builtin_amdgcn_readlane(__float_as_int(v), 0)) + __int_as_float(__builtin_amdgcn_readlane(__float_as_int(v), 32));
}
#define LDS_WAIT() asm volatile("s_waitcnt lgkmcnt(0)" ::: "memory")
__device__ __forceinline__ int tid_fresh(int wv) { unsigned z = 0u; asm volatile("" : "+v"(z)); return wv * 64 + (int)__builtin_amdgcn_mbcnt_hi(~0u, __builtin_amdgcn_mbcnt_lo(~0u, z)); }


#define XB_TMO      128
#define XB_XCNT(j)  (256  + 64 * (j))
#define XB_XSUB(j)  (1280 + 64 * (j))
#define XB_XGEN(j)  (2304 + 64 * (j))
#define XB_TOP      3328
#define XB_TOPGEN   3392
#define XCD_BAR_WORDS 3456
#define XB_SPIN_CAP (1u << 18)
__device__ __forceinline__ unsigned xb_ld(unsigned* p)              { return __hip_atomic_load(p, __ATOMIC_RELAXED, __HIP_MEMORY_SCOPE_AGENT); }
__device__ __forceinline__ unsigned xb_add(unsigned* p, unsigned v) { return __hip_atomic_fetch_add(p, v, __ATOMIC_RELAXED, __HIP_MEMORY_SCOPE_AGENT); }
__device__ __forceinline__ unsigned xb_xcc_id() { return (unsigned)__builtin_amdgcn_s_getreg((3 << 11) | 20) & 0xFu; }
#define XB_SPIN(cond, bar) do { unsigned _sp = 0; while (cond) { __builtin_amdgcn_s_sleep(1); \
    if ((++_sp & 255u) == 0u) { if (xb_ld(&(bar)[XB_TMO])) break; if (_sp > XB_SPIN_CAP) { atomicAdd(&(bar)[XB_TMO], 1u); break; } } } } while (0)
__device__ __forceinline__ void xcd_barrier_complete(unsigned* bar, unsigned x, unsigned& nloc, unsigned& nx) {
    const unsigned G = gridDim.x * gridDim.y * gridDim.z;
    unsigned sum, cnt, mine, sp = 0u;
    for (;;) {
        sum = 0u; cnt = 0u; mine = 0u;
#pragma unroll
        for (unsigned j = 0; j < 16; ++j) { const unsigned c = xb_ld(&bar[XB_XCNT(j)]); sum += c; cnt += (c > 0u) ? 1u : 0u; mine = (j == x) ? c : mine; }
        if (sum == G) break;
        __builtin_amdgcn_s_sleep(1);
        if ((++sp & 255u) == 0u) { if (xb_ld(&bar[XB_TMO])) break; if (sp > XB_SPIN_CAP) { atomicAdd(&bar[XB_TMO], 1u); break; } }
    }
    nloc = mine > 0u ? mine : 1u; nx = cnt > 0u ? cnt : 1u;
}
__device__ __forceinline__ void xcd_barrier(unsigned* bar, volatile LAS unsigned* st, int wv) {
    asm volatile("s_waitcnt vmcnt(0)" ::: "memory");
    __syncthreads();
    if (tid_fresh(wv) == 0) {
        const unsigned x = xb_xcc_id();
        __builtin_amdgcn_s_waitcnt(0);
        unsigned nloc = st[0], nx = st[1];
        if (nloc == 0u) { xcd_barrier_complete(bar, x, nloc, nx); st[0] = nloc; st[1] = nx; }
        const unsigned old = xb_add(&bar[XB_XSUB(x)], 1u);
        const unsigned gen = old / nloc;
        if (old + 1u == (gen + 1u) * nloc) {
            __builtin_amdgcn_fence(__ATOMIC_RELEASE, "agent");
            asm volatile("s_waitcnt vmcnt(0)" ::: "memory");
            const unsigned og = xb_add(&bar[XB_TOP], 1u);
            const unsigned tg = og / nx;
            if (og + 1u == (tg + 1u) * nx) xb_add(&bar[XB_TOPGEN], 1u);
            else XB_SPIN(xb_ld(&bar[XB_TOPGEN]) == tg, bar);
            __builtin_amdgcn_fence(__ATOMIC_ACQUIRE, "agent");
            xb_add(&bar[XB_XGEN(x)], 1u);
            asm volatile("s_waitcnt vmcnt(0)" ::: "memory");
        } else {
            XB_SPIN(xb_ld(&bar[XB_XGEN(x)]) == gen, bar);
            __builtin_amdgcn_fence(__ATOMIC_ACQUIRE, "agent");
            asm volatile("s_waitcnt vmcnt(0)" ::: "memory");
        }
    }
    __syncthreads();
}

constexpr int BM = 256, BK = 64, HALF = 128, HTB = HALF * BK * 2;
__device__ __forceinline__ int lds_byte(int r, int c) { const int st = (r >> 4) * 2 + (c >> 5), rr = r & 15, cc = c & 31, ob = rr * 64 + cc * 2; return st * 1024 + (ob ^ (((ob >> 9) & 1) << 5)); }
__device__ __forceinline__ void stage_rc(int b, int& R, int& C) { const int st = b / 1024, sb = b % 1024, swz = sb ^ (((sb >> 9) & 1) << 5); R = (st >> 1) * 16 + swz / 64; C = (st & 1) * 32 + (swz % 64) / 2; }

__device__ __forceinline__ int perm32(int rho) { const int n = rho >> 4, i = rho & 15; return 8 * (i >> 2) + 4 * n + (i & 3); }
template <class E> struct EpiPerm { static constexpr bool v = false; };
template <int LDA, int LDB, int KK, int NM, int NN, int NBATCH, long SA, long SB>
struct GJob { const bf16_t* A; const bf16_t* B; static constexpr int lda = LDA, ldb = LDB, K = KK, nM = NM, nN = NN, nB = NBATCH; static constexpr long sA = SA, sB = SB; };
struct Unit { int b, pm, pn; };
template <class J>
__device__ __forceinline__ bool unit_at(const J& g, int u, Unit& o) {
    const int per = g.nM * g.nN, nwg = per * g.nB;
    if (u >= nwg) return false;
    int wgid = u; { const int q = nwg / 8, r = nwg % 8, xcd = wgid % 8, off = wgid / 8; wgid = (xcd < r ? xcd * (q + 1) : r * (q + 1) + (xcd - r) * q) + off; }
    o.b = wgid / per; const int w = wgid % per;
    const int nig = 4 * g.nN, gid = w / nig, fm = gid * 4, gsz = (g.nM - fm) < 4 ? (g.nM - fm) : 4;
    o.pm = fm + ((w % nig) % gsz); o.pn = (w % nig) / gsz; return true;
}

#define EPI_LOOP(...) \
    _Pragma("unroll") for (int ai = 0; ai < 2; ++ai) _Pragma("unroll") for (int m = 0; m < 4; ++m) { const int row = u.pm * 256 + ai * 128 + wr * 64 + m * 16 + fr; \
    _Pragma("unroll") for (int bj = 0; bj < 2; ++bj) _Pragma("unroll") for (int n = 0; n < 2; ++n) { const int col = u.pn * 256 + bj * 128 + wc * 32 + n * 16 + 4 * fq; const f32x4 v = acc[ai][bj][m][n]; __VA_ARGS__ } }
#define EPI_SIG const f32x4 (&acc)[2][2][4][2], const Unit& u, int wr, int wc, int fr, int fq

__device__ __forceinline__ void st_bf4(bf16_t* p, f32x4 v) { u32x2 w; w.x = pk2(v[0], v[1]); w.y = pk2(v[2], v[3]); *(u32x2*)p = w; }

struct EpiU {
    static constexpr bool AFTER_DRAIN = false;
    bf16_t* UH;
    __device__ __forceinline__ void operator()(EPI_SIG) const {
#pragma unroll
        for (int ai = 0; ai < 2; ++ai)
#pragma unroll
            for (int m = 0; m < 4; ++m) { const int row = u.pm * 256 + ai * 128 + wr * 64 + m * 16 + fr;
#pragma unroll
                for (int bj = 0; bj < 2; ++bj) { const int col = u.pn * 256 + bj * 128 + wc * 32 + 8 * fq, g = col >> 4, h = col & 15;
                    const f32x4 a = acc[ai][bj][m][0], b = acc[ai][bj][m][1];
                    u32x4 w; w.x = pk2(a[0], a[1]); w.y = pk2(a[2], a[3]); w.z = pk2(b[0], b[1]); w.w = pk2(b[2], b[3]);
                    *(u32x4*)(UH + ((size_t)g * 1024 + (row >> 4)) * 512 + (row & 15) * 16 + h) = w; } }
    }
};
template <> struct EpiPerm<EpiU> { static constexpr bool v = true; };
struct EpiZt {
    static constexpr bool AFTER_DRAIN = false;
    bf16_t* ZT;
    __device__ __forceinline__ void operator()(EPI_SIG) const {
#pragma unroll
        for (int ai = 0; ai < 2; ++ai)
#pragma unroll
            for (int m = 0; m < 4; ++m) { const int row = u.pm * 256 + ai * 128 + wr * 64 + m * 16 + fr;
#pragma unroll
                for (int bj = 0; bj < 2; ++bj) { const int col = u.pn * 256 + bj * 128 + wc * 32 + 8 * fq;
                    const size_t off = (col < NPR) ? ((size_t)(col >> 8) * 65536 + (size_t)row * 256 + (col & 255)) : ((size_t)32 * 65536 + (size_t)((col - NPR) >> 12) * (256 * 4096) + (size_t)row * 4096 + ((col - NPR) & 4095));
                    const f32x4 a = acc[ai][bj][m][0], b = acc[ai][bj][m][1];
                    u32x4 w; w.x = pk2(a[0], a[1]); w.y = pk2(a[2], a[3]); w.z = pk2(b[0], b[1]); w.w = pk2(b[2], b[3]);
                    *(u32x4*)(ZT + off) = w; } }
    }
};
template <> struct EpiPerm<EpiZt> { static constexpr bool v = true; };
struct EpiState {
    static constexpr bool AFTER_DRAIN = false;
    float* S;
    __device__ __forceinline__ void operator()(EPI_SIG) const { EPI_LOOP( *(f32x4*)(S + ((size_t)u.b * 1024 + row) * 256 + col) = v; ) }
};
struct EpiY {
    static constexpr bool AFTER_DRAIN = false;
    bf16_t* G;
    __device__ __forceinline__ void operator()(EPI_SIG) const {
#pragma unroll
        for (int ai = 0; ai < 2; ++ai)
#pragma unroll
            for (int m = 0; m < 4; ++m) { const int row = u.pm * 256 + ai * 128 + wr * 64 + m * 16 + fr;
#pragma unroll
                for (int bj = 0; bj < 2; ++bj) { const int col = u.pn * 256 + bj * 128 + wc * 32 + 8 * fq;
                    const f32x4 a = acc[ai][bj][m][0], b = acc[ai][bj][m][1];
                    u32x4 w; w.x = pk2(gelu_t(a[0]), gelu_t(a[1])); w.y = pk2(gelu_t(a[2]), gelu_t(a[3])); w.z = pk2(gelu_t(b[0]), gelu_t(b[1])); w.w = pk2(gelu_t(b[2]), gelu_t(b[3]));
                    *(u32x4*)(G + (size_t)(row * 16 + (col >> 4)) * 768 + u.b * 16 + (col & 15)) = w; } }
    }
};
struct EpiGlu {
    static constexpr bool AFTER_DRAIN = false;
    const bf16_t* G; const float* bglu; bf16_t* MIX;
    __device__ __forceinline__ void operator()(EPI_SIG) const {
        f32x4 bb[2][2];
#pragma unroll
        for (int bj = 0; bj < 2; ++bj) { const int col = u.pn * 256 + bj * 128 + wc * 32 + 8 * fq; bb[bj][0] = *(const f32x4*)(bglu + col); bb[bj][1] = *(const f32x4*)(bglu + col + 4); }
#pragma unroll
        for (int ai = 0; ai < 2; ++ai) {
            u32x4 gw[4][2];
#pragma unroll
            for (int m = 0; m < 4; ++m)
#pragma unroll
                for (int bj = 0; bj < 2; ++bj) { const int row = u.pm * 256 + ai * 128 + wr * 64 + m * 16 + fr, col = u.pn * 256 + bj * 128 + wc * 32 + 8 * fq;
                    gw[m][bj] = *(const u32x4*)(G + (size_t)row * 768 + col); }
#pragma unroll
            for (int m = 0; m < 4; ++m)
#pragma unroll
                for (int bj = 0; bj < 2; ++bj) { const int row = u.pm * 256 + ai * 128 + wr * 64 + m * 16 + fr, col = u.pn * 256 + bj * 128 + wc * 32 + 8 * fq;
                    const f32x4 a = acc[ai][bj][m][0], b = acc[ai][bj][m][1]; const u32x4 g4 = gw[m][bj];
                    u32x4 w; w.x = pk2(bflo(g4.x) * sigm(a[0] + bb[bj][0][0]), bfhi(g4.x) * sigm(a[1] + bb[bj][0][1])); w.y = pk2(bflo(g4.y) * sigm(a[2] + bb[bj][0][2]), bfhi(g4.y) * sigm(a[3] + bb[bj][0][3]));
                    w.z = pk2(bflo(g4.z) * sigm(b[0] + bb[bj][1][0]), bfhi(g4.z) * sigm(b[1] + bb[bj][1][1])); w.w = pk2(bflo(g4.w) * sigm(b[2] + bb[bj][1][2]), bfhi(g4.w) * sigm(b[3] + bb[bj][1][3]));
                    *(u32x4*)(MIX + (size_t)row * 1280 + col) = w; }
        }
    }
};
struct EpiDft {
    static constexpr bool AFTER_DRAIN = false;
    bf16_t* MIX; int sample; float scale;
    __device__ __forceinline__ void operator()(EPI_SIG) const {
#pragma unroll
        for (int ai = 0; ai < 2; ++ai)
#pragma unroll
            for (int m = 0; m < 4; ++m) { const int row = u.pm * 256 + ai * 128 + wr * 64 + m * 16 + fr, cs = row >> 8, k2 = row & 255;
                const int token = sample ? (NPR + (u.b >> 4) * 4096 + (u.b & 15) + 16 * k2) : (u.b * 256 + k2);
#pragma unroll
                for (int bj = 0; bj < 2; ++bj) { const int col = u.pn * 256 + bj * 128 + wc * 32 + 8 * fq;
                    const f32x4 a = acc[ai][bj][m][0] * scale, b = acc[ai][bj][m][1] * scale;
                    u32x4 w; w.x = pk2(a[0], a[1]); w.y = pk2(a[2], a[3]); w.z = pk2(b[0], b[1]); w.w = pk2(b[2], b[3]);
                    *(u32x4*)(MIX + (size_t)token * 1280 + 768 + (col >> 6) * 128 + cs * 64 + (col & 63)) = w; } }
    }
};
template <> struct EpiPerm<EpiDft> { static constexpr bool v = true; };
struct EpiPlain {
    static constexpr bool AFTER_DRAIN = false;
    bf16_t* O; int ld; const float* bias; int gelu_from;
    __device__ __forceinline__ void operator()(EPI_SIG) const {
        const bool dog = (u.pn * 256) >= gelu_from;
#pragma unroll
        for (int ai = 0; ai < 2; ++ai)
#pragma unroll
            for (int m = 0; m < 4; ++m) { const int row = u.pm * 256 + ai * 128 + wr * 64 + m * 16 + fr;
#pragma unroll
                for (int bj = 0; bj < 2; ++bj) { const int col = u.pn * 256 + bj * 128 + wc * 32 + 8 * fq;
                    f32x4 a = acc[ai][bj][m][0], b = acc[ai][bj][m][1];
                    if (dog) {
#pragma unroll
                        for (int e = 0; e < 4; ++e) { a[e] = gelu_t(a[e]); b[e] = gelu_t(b[e]); } }
                    u32x4 w; w.x = pk2(a[0], a[1]); w.y = pk2(a[2], a[3]); w.z = pk2(b[0], b[1]); w.w = pk2(b[2], b[3]);
                    *(u32x4*)(O + (size_t)row * ld + col) = w; } }
    }
};
struct EpiRelu2 {
    static constexpr bool AFTER_DRAIN = false;
    bf16_t* O;
    __device__ __forceinline__ void operator()(EPI_SIG) const {
#pragma unroll
        for (int ai = 0; ai < 2; ++ai)
#pragma unroll
            for (int m = 0; m < 4; ++m) { const int row = u.pm * 256 + ai * 128 + wr * 64 + m * 16 + fr;
#pragma unroll
                for (int bj = 0; bj < 2; ++bj) { const int col = u.pn * 256 + bj * 128 + wc * 32 + 8 * fq;
                    f32x4 a = acc[ai][bj][m][0], b = acc[ai][bj][m][1];
#pragma unroll
                    for (int e = 0; e < 4; ++e) { a[e] = fmaxf(a[e], 0.f); b[e] = fmaxf(b[e], 0.f); }
                    a = a * a; b = b * b;
                    u32x4 w; w.x = pk2(a[0], a[1]); w.y = pk2(a[2], a[3]); w.z = pk2(b[0], b[1]); w.w = pk2(b[2], b[3]);
                    *(u32x4*)(O + (size_t)row * DFF + col) = w; } }
    }
};
template <> struct EpiPerm<EpiRelu2> { static constexpr bool v = true; };
template <> struct EpiPerm<EpiPlain> { static constexpr bool v = true; };
template <> struct EpiPerm<EpiY> { static constexpr bool v = true; };
template <> struct EpiPerm<EpiGlu> { static constexpr bool v = true; };
struct EpiResNorm;
template <> struct EpiPerm<EpiResNorm> { static constexpr bool v = true; };
struct EpiGmlp {
    static constexpr bool AFTER_DRAIN = false;
    const bf16_t* ZUV; const float* bs; bf16_t* MIX;
    __device__ __forceinline__ void operator()(EPI_SIG) const {
#pragma unroll
        for (int ai = 0; ai < 2; ++ai) {
            const int head = u.b * 2 + ai;
#pragma unroll
            for (int m = 0; m < 4; ++m) { const int q = wr * 64 + m * 16 + fr; const float b = bs[head * 128 + q];
                u32x4 uw[2];
#pragma unroll
                for (int bj = 0; bj < 2; ++bj) { const int col = u.pn * 256 + bj * 128 + wc * 32 + 8 * fq, token = (col >> 7) * 128 + q, d = col & 127;
                    uw[bj] = *(const u32x4*)(ZUV + (size_t)token * 1536 + 512 + head * 128 + d); }
#pragma unroll
                for (int bj = 0; bj < 2; ++bj) { const int col = u.pn * 256 + bj * 128 + wc * 32 + 8 * fq, token = (col >> 7) * 128 + q, d = col & 127;
                    const f32x4 va = acc[ai][bj][m][0], vb = acc[ai][bj][m][1]; const u32x4 w4 = uw[bj];
                    u32x4 o; o.x = pk2(bflo(w4.x) * (va[0] + b), bfhi(w4.x) * (va[1] + b)); o.y = pk2(bflo(w4.y) * (va[2] + b), bfhi(w4.y) * (va[3] + b));
                    o.z = pk2(bflo(w4.z) * (vb[0] + b), bfhi(w4.z) * (vb[1] + b)); o.w = pk2(bflo(w4.w) * (vb[2] + b), bfhi(w4.w) * (vb[3] + b));
                    *(u32x4*)(MIX + (size_t)token * 1024 + 512 + head * 128 + d) = o; }
                asm volatile("" ::: "memory"); }
        }
    }
};
template <> struct EpiPerm<EpiGmlp> { static constexpr bool v = true; };

struct RowStat {
    float* slots; unsigned* cnt;
    __device__ __forceinline__ void run(const f32x4 (&v)[2][2][4][2], const Unit& u, int wr, int wc, int fr, int fq, LAS unsigned char* lds, int tid) const {
        LAS float* P = (LAS float*)lds;
        LAS float* S = (LAS float*)(lds + 16384);
#pragma unroll
        for (int ai = 0; ai < 2; ++ai)
#pragma unroll
            for (int m = 0; m < 4; ++m) { float sq = 0.f;
#pragma unroll
                for (int bj = 0; bj < 2; ++bj)
#pragma unroll
                    for (int n = 0; n < 2; ++n) { const f32x4 x = v[ai][bj][m][n]; sq += (x[0] * x[0] + x[1] * x[1]) + (x[2] * x[2] + x[3] * x[3]); }
                P[(ai * 128 + wr * 64 + m * 16 + fr) * 16 + wc * 4 + fq] = sq; }
        asm volatile("s_waitcnt lgkmcnt(0)" ::: "memory"); __builtin_amdgcn_s_barrier(); asm volatile("" ::: "memory");
        if (tid < 256) {
            const LAS f32x4* pr = (const LAS f32x4*)(P + tid * 16); const f32x4 a = pr[0], b = pr[1], c2 = pr[2], d = pr[3];
            const float tot = ((a[0] + a[1]) + (a[2] + a[3])) + ((b[0] + b[1]) + (b[2] + b[3])) + ((c2[0] + c2[1]) + (c2[2] + c2[3])) + ((d[0] + d[1]) + (d[2] + d[3]));
            __hip_atomic_store(slots + ((size_t)(u.pm * 256 + tid) * 4 + u.pn), tot, __ATOMIC_RELAXED, __HIP_MEMORY_SCOPE_AGENT);
            asm volatile("s_waitcnt vmcnt(0)" ::: "memory");
            if ((tid & 63) == 0) __hip_atomic_fetch_add(cnt + 16 * u.pm, 1u, __ATOMIC_RELAXED, __HIP_MEMORY_SCOPE_AGENT);
        }
        if (tid < 64) {
            unsigned sp = 0;
            while ((unsigned)__builtin_amdgcn_readfirstlane(__hip_atomic_load(cnt + 16 * u.pm, __ATOMIC_RELAXED, __HIP_MEMORY_SCOPE_AGENT)) < 16u) { __builtin_amdgcn_s_sleep(1); if (++sp > (1u << 22)) break; }
            __builtin_amdgcn_fence(__ATOMIC_ACQUIRE, "agent");
        }
        asm volatile("s_waitcnt vmcnt(0) lgkmcnt(0)" ::: "memory"); __builtin_amdgcn_s_barrier(); asm volatile("" ::: "memory");
        if (tid < 256) {
            const float* sl = slots + (size_t)(u.pm * 256 + tid) * 4; float tot = 0.f;
#pragma unroll
            for (int t = 0; t < 4; ++t) tot += __hip_atomic_load(sl + t, __ATOMIC_RELAXED, __HIP_MEMORY_SCOPE_AGENT);
            S[tid] = __builtin_amdgcn_rsqf(tot * (1.f / 1024.f) + EPS);
        }
        asm volatile("s_waitcnt vmcnt(0) lgkmcnt(0)" ::: "memory"); __builtin_amdgcn_s_barrier(); asm volatile("" ::: "memory");
    }
};
struct EpiResNorm {
    static constexpr bool AFTER_DRAIN = true;
    float* X; bf16_t* H; const float* bias; const float* mod; int gate_off; const float* g_post; const float* mod_next; int pre_off; const float* g_pre; RowStat st1, st2; int next;
    __device__ __forceinline__ void fused(f32x4 (&acc)[2][2][4][2], const Unit& u, int wr, int wc, int fr, int fq, LAS unsigned char* lds, int tid) const {
        const LAS float* S = (const LAS float*)(lds + 16384);
        const int cond = (u.pm < 32) ? 0 : 1 + ((u.pm - 32) >> 4);
        const int col0 = u.pn * 256 + wc * 32 + 8 * fq;
        if (bias) {
#pragma unroll
            for (int bj = 0; bj < 2; ++bj)
#pragma unroll
                for (int n = 0; n < 2; ++n) { const f32x4 bv = *(const f32x4*)(bias + col0 + bj * 128 + n * 4);
#pragma unroll
                    for (int ai = 0; ai < 2; ++ai)
#pragma unroll
                        for (int m = 0; m < 4; ++m) acc[ai][bj][m][n] += bv; }
        }
        st1.run(acc, u, wr, wc, fr, fq, lds, tid);
        const float* gt = mod + cond * 6144 + gate_off;
        {
            f32x4 gv[4];
#pragma unroll
            for (int q = 0; q < 4; ++q) { const int co = (q >> 1) * 128 + (q & 1) * 4; gv[q] = *(const f32x4*)(gt + col0 + co) * *(const f32x4*)(g_post + col0 + co); }
#pragma unroll
            for (int ai = 0; ai < 2; ++ai)
#pragma unroll
                for (int mp = 0; mp < 2; ++mp) {
                    f32x4 xv[2][4];
#pragma unroll
                    for (int mm = 0; mm < 2; ++mm) { const int r = ai * 128 + wr * 64 + (mp * 2 + mm) * 16 + fr; const float* xp = X + (size_t)(u.pm * 256 + r) * DM + col0;
#pragma unroll
                        for (int q = 0; q < 4; ++q) xv[mm][q] = *(const f32x4*)(xp + (q >> 1) * 128 + (q & 1) * 4); }
#pragma unroll
                    for (int mm = 0; mm < 2; ++mm) { const int m = mp * 2 + mm, r = ai * 128 + wr * 64 + m * 16 + fr; const float r1 = S[r]; float* xp = X + (size_t)(u.pm * 256 + r) * DM + col0;
#pragma unroll
                        for (int q = 0; q < 4; ++q) { const f32x4 xn = xv[mm][q] + gv[q] * (acc[ai][q >> 1][m][q & 1] * r1); *(f32x4*)(xp + (q >> 1) * 128 + (q & 1) * 4) = xn; acc[ai][q >> 1][m][q & 1] = xn; } }
                    asm volatile("" ::: "memory"); }
        }
        if (next) {
            st2.run(acc, u, wr, wc, fr, fq, lds, tid);
            const float* sh = mod_next + cond * 6144 + pre_off; const float* sc = sh + 1024;
            f32x4 av[4], s0[4];
#pragma unroll
            for (int q = 0; q < 4; ++q) { const int co = (q >> 1) * 128 + (q & 1) * 4; av[q] = *(const f32x4*)(g_pre + col0 + co) * (1.f + *(const f32x4*)(sc + col0 + co)); s0[q] = *(const f32x4*)(sh + col0 + co); }
#pragma unroll
            for (int ai = 0; ai < 2; ++ai)
#pragma unroll
                for (int m = 0; m < 4; ++m) { const int r = ai * 128 + wr * 64 + m * 16 + fr; const float r2 = S[r]; bf16_t* hp = H + (size_t)(u.pm * 256 + r) * DM + col0;
#pragma unroll
                    for (int bj = 0; bj < 2; ++bj) { const f32x4 h0 = acc[ai][bj][m][0] * r2 * av[2 * bj] + s0[2 * bj], h1 = acc[ai][bj][m][1] * r2 * av[2 * bj + 1] + s0[2 * bj + 1];
                        u32x4 w; w.x = pk2(h0[0], h0[1]); w.y = pk2(h0[2], h0[3]); w.z = pk2(h1[0], h1[1]); w.w = pk2(h1[2], h1[3]); *(u32x4*)(hp + bj * 128) = w; } }
        }
    }
};

template <class J, class Epi>
__device__ __forceinline__ void gemm_phase(LAS unsigned char* lds, const J g, int ubase, int c, int G, const Epi& E, int wv) {
    const int tid = tid_fresh(wv), wid = __builtin_amdgcn_readfirstlane(tid >> 6), lane = tid & 63, wr = wid >> 2, wc = wid & 3, fr = lane & 15, fq = lane >> 4;
    const int K = g.K, nt = K / BK;
    int u0; { int i0 = (ubase > c) ? (ubase - c + G - 1) / G : 0; u0 = c + i0 * G - ubase; }
    Unit cur, nxt; int ui = 0;
    if (!unit_at(g, u0, cur)) return;
    unsigned voffA[2], voffB[2];
#pragma unroll
    for (int i = 0; i < 2; ++i) { int R, C; stage_rc(tid * 16 + i * 8192, R, C); const int Rb = EpiPerm<Epi>::v ? ((R & ~31) + perm32(R & 31)) : R; voffA[i] = (unsigned)(R * g.lda + C) * 2u; voffB[i] = (unsigned)(Rb * g.ldb + C) * 2u; }
    const size_t kstep = (size_t)(BK * 2);
    const size_t hstepA = (size_t)HALF * g.lda * 2, hstepB = (size_t)HALF * g.ldb * 2;
    const unsigned ldsw = (unsigned)wid * 1024u;
    const int aoff = lds_byte(wr * 64 + fr, fq * 8), boff = lds_byte(wc * 32 + fr, fq * 8);
#define PG8_SA(b, h) (((b) * 2 + (h)) * HTB)
#define PG8_SB(b, h) ((4 + (b) * 2 + (h)) * HTB)
#define PG8_STAGE(bufoff, gbase, voff) do { _Pragma("unroll") for (int _i = 0; _i < 2; ++_i) \
        __builtin_amdgcn_global_load_lds((const unsigned*)((const char*)(gbase) + (voff)[_i]), (LAS unsigned*)(lds + (bufoff) + ldsw + _i * 8192), 16, 0, 0); } while (0)
#define PG8_LDA(dst, b, h) do { _Pragma("unroll") for (int m = 0; m < 4; ++m) _Pragma("unroll") for (int k = 0; k < 2; ++k) dst[m][k] = *(const LAS bf16x8*)(lds + PG8_SA(b, h) + aoff + m * 2048 + k * 1024); } while (0)
#define PG8_LDB(dst, b, h) do { _Pragma("unroll") for (int n = 0; n < 2; ++n) _Pragma("unroll") for (int k = 0; k < 2; ++k) dst[n][k] = *(const LAS bf16x8*)(lds + PG8_SB(b, h) + boff + n * 2048 + k * 1024); } while (0)
#define PG8_MMA(ai, bj, At, Bt) do { __builtin_amdgcn_s_setprio(1); _Pragma("unroll") for (int m = 0; m < 4; ++m) _Pragma("unroll") for (int n = 0; n < 2; ++n) _Pragma("unroll") for (int k = 0; k < 2; ++k) \
        acc[ai][bj][m][n] = __builtin_amdgcn_mfma_f32_16x16x32_bf16(Bt[n][k], At[m][k], acc[ai][bj][m][n], 0, 0, 0); __builtin_amdgcn_s_setprio(0); } while (0)
#define PG8_WAIT_V(n) asm volatile("s_waitcnt vmcnt(" #n ")" ::: "memory")
#define PG8_WAIT_L(n) asm volatile("s_waitcnt lgkmcnt(" #n ")" ::: "memory")
#define PG8_BAR __builtin_amdgcn_s_barrier()
#define PG8_SCHED __builtin_amdgcn_sched_barrier(0)
    f32x4 acc[2][2][4][2];
#pragma unroll
    for (int a = 0; a < 2; ++a)
#pragma unroll
        for (int b = 0; b < 2; ++b)
#pragma unroll
            for (int m = 0; m < 4; ++m)
#pragma unroll
                for (int n = 0; n < 2; ++n) acc[a][b][m][n] = (f32x4){0.f, 0.f, 0.f, 0.f};
    bf16x8 At[4][2], B0[2][2], B1[2][2];
    const char* cA = (const char*)(g.A + (size_t)cur.b * g.sA) + (size_t)cur.pm * 2 * hstepA;
    const char* cB = (const char*)(g.B + (size_t)cur.b * g.sB) + (size_t)cur.pn * 2 * hstepB;
    PG8_STAGE(PG8_SB(0, 0), cB, voffB); PG8_STAGE(PG8_SA(0, 0), cA, voffA); PG8_STAGE(PG8_SB(0, 1), cB + hstepB, voffB); PG8_STAGE(PG8_SA(0, 1), cA + hstepA, voffA);
    if (wr == 1) PG8_BAR;
    PG8_WAIT_V(4); PG8_BAR;
    PG8_STAGE(PG8_SB(1, 0), cB + kstep, voffB); PG8_STAGE(PG8_SA(1, 0), cA + kstep, voffA); PG8_STAGE(PG8_SB(1, 1), cB + hstepB + kstep, voffB);
    PG8_WAIT_V(6); PG8_BAR;
    for (;;) {
        const bool has_next = unit_at(g, u0 + (ui + 1) * G, nxt);
        const char* nA = has_next ? (const char*)(g.A + (size_t)nxt.b * g.sA) + (size_t)nxt.pm * 2 * hstepA : cA;
        const char* nB = has_next ? (const char*)(g.B + (size_t)nxt.b * g.sB) + (size_t)nxt.pn * 2 * hstepB : cB;
        for (int t = 0; t < nt; t += 2) {
            const bool last = (t == nt - 2);
            const char* a1 = cA + (size_t)(t + 1) * kstep;
            const char* a2 = last ? nA : cA + (size_t)(t + 2) * kstep; const char* b2 = last ? nB : cB + (size_t)(t + 2) * kstep;
            const char* a3 = a2 + kstep; const char* b3 = b2 + kstep;
            PG8_LDB(B0, 0, 0); PG8_SCHED; PG8_LDA(At, 0, 0); PG8_STAGE(PG8_SA(1, 1), a1 + hstepA, voffA);
            PG8_WAIT_L(8); PG8_BAR; PG8_WAIT_L(0); PG8_MMA(0, 0, At, B0); PG8_BAR; PG8_SCHED;
            PG8_LDB(B1, 0, 1); PG8_STAGE(PG8_SB(0, 0), b2, voffB);
            PG8_BAR; PG8_WAIT_L(0); PG8_MMA(0, 1, At, B1); PG8_BAR;
            PG8_LDA(At, 0, 1); PG8_STAGE(PG8_SA(0, 0), a2, voffA);
            PG8_BAR; PG8_WAIT_L(0); PG8_MMA(1, 0, At, B0); PG8_BAR; PG8_SCHED;
            PG8_STAGE(PG8_SB(0, 1), b2 + hstepB, voffB);
            PG8_WAIT_V(6); PG8_BAR; PG8_MMA(1, 1, At, B1); PG8_BAR;
            PG8_LDB(B0, 1, 0); PG8_SCHED; PG8_LDA(At, 1, 0); PG8_STAGE(PG8_SA(0, 1), a2 + hstepA, voffA);
            PG8_WAIT_L(8); PG8_BAR; PG8_WAIT_L(0); PG8_MMA(0, 0, At, B0); PG8_BAR; PG8_SCHED;
            PG8_LDB(B1, 1, 1); PG8_STAGE(PG8_SB(1, 0), b3, voffB);
            PG8_BAR; PG8_WAIT_L(0); PG8_MMA(0, 1, At, B1); PG8_BAR;
            PG8_LDA(At, 1, 1); PG8_STAGE(PG8_SA(1, 0), a3, voffA);
            PG8_BAR; PG8_WAIT_L(0); PG8_MMA(1, 0, At, B0); PG8_BAR; PG8_SCHED;
            PG8_STAGE(PG8_SB(1, 1), b3 + hstepB, voffB);
            PG8_WAIT_V(6); PG8_BAR; PG8_MMA(1, 1, At, B1); PG8_BAR;
        }
        if constexpr (!Epi::AFTER_DRAIN) E(acc, cur, wr, wc, fr, fq);
        if (!has_next) break;
#pragma unroll
        for (int a = 0; a < 2; ++a)
#pragma unroll
            for (int b = 0; b < 2; ++b)
#pragma unroll
                for (int m = 0; m < 4; ++m)
#pragma unroll
                    for (int n = 0; n < 2; ++n) acc[a][b][m][n] = (f32x4){0.f, 0.f, 0.f, 0.f};
        cur = nxt; cA = nA; cB = nB; ++ui;
    }
    PG8_WAIT_V(0);
    if (wr == 0) PG8_BAR;
    PG8_BAR;
    if constexpr (Epi::AFTER_DRAIN) E.fused(acc, cur, wr, wc, fr, fq, lds, tid);
#undef PG8_SA
#undef PG8_SB
#undef PG8_STAGE
#undef PG8_LDA
#undef PG8_LDB
#undef PG8_MMA
#undef PG8_WAIT_V
#undef PG8_WAIT_L
#undef PG8_BAR
#undef PG8_SCHED
}

__device__ __forceinline__ void transpose_item(const float* W, int ldw, int Nsrc, bf16_t* WT, int ldt, int koff, LAS float* scrf, int item, int lane) {
    LAS unsigned* scr = (LAS unsigned*)scrf;
    const int nblk = Nsrc / 64, kb = item / nblk, nb = item % nblk, k0 = 64 * kb, n0 = 64 * nb, r = lane >> 4, cq = (lane & 15) * 4;
    { const float* src = W + (size_t)(k0 + r) * ldw + n0 + cq; f32x4 v[16];
#pragma unroll
      for (int i = 0; i < 16; ++i) v[i] = *(const f32x4*)(src + (size_t)(4 * i) * ldw);
#pragma unroll
      for (int i = 0; i < 16; ++i) { const int k = 4 * i + r; LAS unsigned* d2 = scr + k * 33 + (cq >> 1); d2[0] = pk2(v[i][0], v[i][1]); d2[1] = pk2(v[i][2], v[i][3]); } }
    LDS_WAIT();
    const int c8 = lane & 7, np = lane >> 3;
#pragma unroll
    for (int j = 0; j < 4; ++j) { const int n2 = j * 8 + np;
        unsigned w[8];
#pragma unroll
        for (int e = 0; e < 8; ++e) w[e] = scr[(c8 * 8 + e) * 33 + n2];
        u32x4 lo, hi;
        lo.x = (w[0] & 0xffffu) | (w[1] << 16); lo.y = (w[2] & 0xffffu) | (w[3] << 16); lo.z = (w[4] & 0xffffu) | (w[5] << 16); lo.w = (w[6] & 0xffffu) | (w[7] << 16);
        hi.x = (w[0] >> 16) | (w[1] & 0xffff0000u); hi.y = (w[2] >> 16) | (w[3] & 0xffff0000u); hi.z = (w[4] >> 16) | (w[5] & 0xffff0000u); hi.w = (w[6] >> 16) | (w[7] & 0xffff0000u);
        bf16_t* dst = WT + (size_t)(n0 + 2 * n2) * ldt + koff + k0 + 8 * c8;
        *(u32x4*)dst = lo; *(u32x4*)(dst + ldt) = hi; }
    LDS_WAIT();
}

template <int D>
__device__ __forceinline__ void fold_item(const float* coef, const float* scale, const float* W, int ldw, bf16_t* dst, LAS float* scr, int lane) {
    float acc[16];
#pragma unroll
    for (int i = 0; i < 16; ++i) acc[i] = 0.f;
#pragma unroll 1
    for (int dc = 0; dc < D; dc += 64) {
        float cr[16]; const float sc = scale ? scale[dc + lane] : 1.f;
#pragma unroll
        for (int i = 0; i < 16; ++i) cr[i] = coef[(size_t)i * D + dc + lane];
        { float v[64];
#pragma unroll
          for (int d = 0; d < 64; ++d) v[d] = W[(size_t)(dc + d) * ldw + lane];
#pragma unroll
          for (int d = 0; d < 64; ++d) scr[d * 64 + lane] = v[d]; }
#pragma unroll
        for (int i = 0; i < 16; ++i) cr[i] *= sc;
        LDS_WAIT();
#pragma unroll 8
        for (int d = 0; d < 64; ++d) { const float w = scr[d * 64 + lane];
#pragma unroll
            for (int i = 0; i < 16; ++i) acc[i] += __int_as_float(__builtin_amdgcn_readlane(__float_as_int(cr[i]), d)) * w; }
        LDS_WAIT();
    }
    u32x4 o0, o1; o0.x = pk2(acc[0], acc[1]); o0.y = pk2(acc[2], acc[3]); o0.z = pk2(acc[4], acc[5]); o0.w = pk2(acc[6], acc[7]);
    o1.x = pk2(acc[8], acc[9]); o1.y = pk2(acc[10], acc[11]); o1.z = pk2(acc[12], acc[13]); o1.w = pk2(acc[14], acc[15]);
    *(u32x4*)dst = o0; *(u32x4*)(dst + 8) = o1;
}

__device__ __forceinline__ void row_pass0(const Params& p, float* X, bf16_t* HY, const float* mod_next, const float* g_pre, int gw, int nw, int lane) {
    for (int row0 = gw; row0 < NTOK; row0 += 4 * nw) {
        f32x4 x[4][4];
#pragma unroll
        for (int r = 0; r < 4; ++r) { const int row = row0 + r * nw; if (row >= NTOK) continue;
            const float* src = (row < NPR) ? (p.in[0] + (size_t)row * DM + 4 * lane) : (p.in[1] + (size_t)(row - NPR) * DM + 4 * lane);
#pragma unroll
            for (int j = 0; j < 4; ++j) x[r][j] = *(const f32x4*)(src + 256 * j); }
#pragma unroll
        for (int r = 0; r < 4; ++r) { const int row = row0 + r * nw; if (row >= NTOK) continue;
            const int cond = row < NPR ? 0 : 1 + ((row - NPR) >> 12);
            float* xr = X + (size_t)row * DM + 4 * lane;
            if (row >= NPR) { const int t = (row - NPR) & 4095; const float pr = (float)(t >> 6), pc = (float)(t & 63);
#pragma unroll
                for (int j = 0; j < 4; ++j)
#pragma unroll
                    for (int e = 0; e < 4; ++e) { const int i = 4 * lane + e; const float om = __builtin_amdgcn_exp2f(-(float)i * (13.287712379549449f / 256.f));
                        const float ang = ((j < 2) ? pr : pc) * om; float sn, cn; sincos_rev(ang * 0.15915494309189535f, sn, cn); x[r][j][e] += (j & 1) ? cn : sn; } }
            float ss = 0.f;
#pragma unroll
            for (int j = 0; j < 4; ++j) { *(f32x4*)(xr + 256 * j) = x[r][j]; ss += (x[r][j][0] * x[r][j][0] + x[r][j][1] * x[r][j][1]) + (x[r][j][2] * x[r][j][2] + x[r][j][3] * x[r][j][3]); }
            const float rstd = __builtin_amdgcn_rsqf(wave_sum(ss) * (1.f / DM) + EPS);
            const float* sh = mod_next + cond * 6144 + 4 * lane; const float* sc = sh + 1024;
            bf16_t* hr = HY + (size_t)row * DM + 4 * lane;
#pragma unroll
            for (int j = 0; j < 4; ++j) { const f32x4 gp = *(const f32x4*)(g_pre + 4 * lane + 256 * j); const f32x4 s1 = *(const f32x4*)(sc + 256 * j); const f32x4 s0 = *(const f32x4*)(sh + 256 * j);
                st_bf4(hr + 256 * j, x[r][j] * rstd * gp * (1.f + s1) + s0); }
        }
    }
}

constexpr int CI0 = 16 * 16  , CI1 = CI0 + 12 * 12  , CI2 = CI1 + 12 * 16  , CI3 = CI2 + 16 * 24  , CI4 = CI3 + 16 * 64  ,
              CI5 = CI4 + 64 * 16  , CI6 = CI5 + 8 * 16  ;
#define CONV_ITEMS(LO, HI, WIDX, NWV) do { for (int it_ = (LO) + (WIDX); it_ < (HI); it_ += (NWV)) { \
        if (it_ < CI0) transpose_item(p.in[14], 1024, 1024, WIN0, 1024, 0, scr, it_, lane); \
        else if (it_ < CI1) transpose_item(p.in[24], 768, 768, WGLU, 768, 0, scr, it_ - CI0, lane); \
        else if (it_ < CI2) transpose_item(p.in[15], 1024, 1024, WOUT0, 1280, 0, scr, it_ - CI1, lane); \
        else if (it_ < CI3) transpose_item(p.in[36], 1536, 1536, WIN1, 1024, 0, scr, it_ - CI2, lane); \
        else if (it_ < CI4) transpose_item(p.in[12], 4096, 4096, WFF1, 1024, 0, scr, it_ - CI3, lane); \
        else if (it_ < CI5) transpose_item(p.in[13], 1024, 1024, WFF2, 4096, 0, scr, it_ - CI4, lane); \
        else transpose_item(p.in[37] + (size_t)512 * 1024, 1024, 1024, WOUT1, 1024, 512, scr, it_ - CI5, lane); } } while (0)
#define FOLD_ITEMS(LO, HI, WIDX, NWV) do { for (int it_ = (LO) + (WIDX); it_ < (HI); it_ += (NWV)) { \
        if (it_ < 16) { const int n = it_ * 64 + lane; float sm = 0.f; \
            _Pragma("unroll 1") for (int jc = 0; jc < 256; jc += 64) { const float fb = p.in[27][jc + lane]; float v[64]; \
                _Pragma("unroll") for (int j = 0; j < 64; ++j) v[j] = p.in[15][(size_t)(768 + jc + j) * 1024 + n]; \
                _Pragma("unroll") for (int j = 0; j < 64; ++j) sm += __int_as_float(__builtin_amdgcn_readlane(__float_as_int(fb), j)) * v[j]; } \
            BIAS0[n] = sm; } \
        else { const int it = it_ - 16; const int nb = it & 15, cb = (it >> 4) & 7, g = it >> 7, n = nb * 64 + lane; \
            fold_item<128>(p.in[38] + (size_t)(g * 128 + cb * 16) * 128, p.in[39] + g * 128, p.in[37] + (size_t)(g * 128) * 1024 + nb * 64, 1024, WOUT1 + (size_t)n * 1024 + g * 128 + cb * 16, scr, lane); } } } while (0)

__global__ void __launch_bounds__(512, 2) mega_fwd(Params p) {
    extern __shared__ __attribute__((aligned(16))) unsigned char smem[];
    LAS unsigned char* lds = (LAS unsigned char*)smem;
    cg::grid_group grid = cg::this_grid();
    const int wv = __builtin_amdgcn_readfirstlane((int)(threadIdx.x >> 6));
    volatile LAS unsigned* xb_st = (volatile LAS unsigned*)(lds + 131072);
    unsigned* xb_bar = (unsigned*)(p.ws + WS_BAR);
    if (threadIdx.x == 0) { xb_st[0] = 0u; xb_st[1] = 0u; (void)xb_add(&xb_bar[XB_XCNT(xb_xcc_id())], 1u); }
    __syncthreads();
    if (p.ws == nullptr) grid.sync();
#define GSYNC() xcd_barrier((unsigned*)(p.ws + WS_BAR), (volatile LAS unsigned*)(lds + 131072), wv)
    const int G = gridDim.x, c = blockIdx.x, GT = G * 512, NW = G * 8;
#define PHASE_PTRS unsigned long long wz_ = 0; asm volatile("" : "+s"(wz_)); unsigned char* ws = p.ws + wz_; \
    float* X = p.out; \
    bf16_t* WFF1 = (bf16_t*)(ws + WS_WFF1); bf16_t* WFF2 = (bf16_t*)(ws + WS_WFF2); bf16_t* WIN0 = (bf16_t*)(ws + WS_WIN0); bf16_t* WGLU = (bf16_t*)(ws + WS_WGLU); \
    bf16_t* WOUT0 = (bf16_t*)(ws + WS_WOUT0); bf16_t* WIN1 = (bf16_t*)(ws + WS_WIN1); bf16_t* WOUT1 = (bf16_t*)(ws + WS_WOUT1); \
    bf16_t* ME = (bf16_t*)(ws + WS_ME); bf16_t* SG = (bf16_t*)(ws + WS_SG); bf16_t* D512 = (bf16_t*)(ws + WS_D512); bf16_t* A2 = (bf16_t*)(ws + WS_A2); \
    float* MOD = (float*)(ws + WS_MOD); f32x2* APOW = (f32x2*)(ws + WS_APOW); f32x2* BBT = (f32x2*)(ws + WS_BBT); float* KTAB = (float*)(ws + WS_KTAB); \
    float* CSW = (float*)(ws + WS_CSW); float* BIAS0 = (float*)(ws + WS_BIAS0); \
    bf16_t* HY = (bf16_t*)(ws + WS_HY); bf16_t* MIX = (bf16_t*)(ws + WS_MIX); \
    bf16_t* UH = (bf16_t*)(ws + WS_UH); float* SLOC = (float*)(ws + WS_SLOC); bf16_t* GB = (bf16_t*)(ws + WS_G); \
    bf16_t* ZT = (bf16_t*)(ws + WS_ZT); bf16_t* YT = (bf16_t*)(ws + WS_YT); bf16_t* ZUV = (bf16_t*)(ws + WS_ZUV); bf16_t* VT = (bf16_t*)(ws + WS_VT); \
    bf16_t* HMID = (bf16_t*)(ws + WS_HMID);
#define PHASE_IDS PHASE_PTRS const int tid = tid_fresh(wv), lane = tid & 63, wave = __builtin_amdgcn_readfirstlane(tid >> 6), gtid = c * 512 + tid, gw = wave * G + c; \
    LAS float* scr = (LAS float*)(lds + wave * 16384); (void)lane; (void)gtid; (void)gw; (void)scr;
#pragma unroll 1
    for (int rep = 0; rep < REP_P0; ++rep) {
        PHASE_IDS
        for (int cgi = c; cgi < 192; cgi += G) {
            const int layer = cgi / 96, r96 = cgi % 96, strip = r96 % 12, ks = r96 / 12;
            LAS float* sl = (LAS float*)lds; LAS float* red = sl + 3072;
            for (int i = tid; i < 3072; i += 512) { const int cd = i >> 10, k = i & 1023; const float v = (cd == 0) ? PIN(5)[k] : PIN(4)[(cd - 1) * 1024 + k]; sl[i] = v * sigm(v); }
            __syncthreads();
            const float* Wm = PIN(layer ? 28 : 6) + (size_t)(ks * 128 + wave * 16) * 6144 + strip * 512 + lane * 4;
            f32x4 a0 = {0.f, 0.f, 0.f, 0.f}, a1 = a0, a2 = a0, b0 = a0, b1 = a0, b2 = a0;
#pragma unroll
            for (int i = 0; i < 16; ++i) { const int k = ks * 128 + wave * 16 + i; const f32x4 w0 = *(const f32x4*)(Wm + (size_t)i * 6144), w1 = *(const f32x4*)(Wm + (size_t)i * 6144 + 256);
                const float s0 = sl[k], s1 = sl[1024 + k], s2 = sl[2048 + k]; a0 += s0 * w0; a1 += s1 * w0; a2 += s2 * w0; b0 += s0 * w1; b1 += s1 * w1; b2 += s2 * w1; }
            { LAS float* r = red + wave * 1536 + lane * 4; *(LAS f32x4*)r = a0; *(LAS f32x4*)(r + 256) = b0; *(LAS f32x4*)(r + 512) = a1; *(LAS f32x4*)(r + 768) = b1; *(LAS f32x4*)(r + 1024) = a2; *(LAS f32x4*)(r + 1280) = b2; }
            __syncthreads();
            for (int o = tid; o < 1536; o += 512) { const int cd = o >> 9, col = o & 511; float sm = (ks == 0) ? PIN(layer ? 29 : 7)[strip * 512 + col] : 0.f;
#pragma unroll
                for (int w = 0; w < 8; ++w) sm += red[w * 1536 + o];
                atomicAdd(MOD + (layer * 3 + cd) * 6144 + strip * 512 + col, sm); }
            __syncthreads();
        }
        const int hb = c - 204, nhb = G - 204;
        if (hb >= 0) CONV_ITEMS(0, CI1, hb * 8 + wave, nhb * 8);
        if (hb >= 0) for (int idx = hb * 512 + tid; idx < 32768; idx += nhb * 512) {
            const int d = idx & 63, cc = (idx >> 6) & 63, cs = (idx >> 12) & 1, g = idx >> 13; float sm = 0.f;
            const float* fw = PIN(26) + (size_t)(g * 64) * 64 + d;
#pragma unroll
            for (int m0 = 0; m0 < 64; m0 += 16) { float w[16];
#pragma unroll
                for (int k = 0; k < 16; ++k) w[k] = fw[(m0 + k) * 64];
#pragma unroll
                for (int k = 0; k < 16; ++k) { float sn, cn; sincos_rev((float)(((m0 + k) * cc) & 63) * (1.f / 64.f), sn, cn); sm += (cs ? sn : cn) * w[k]; } }
            CSW[idx] = sm;
        }
        for (int idx = gtid; idx < 131072; idx += GT) {
            const int kk = idx & 127, hp = (idx >> 7) & 1, q = (idx >> 8) & 127, h = (idx >> 15) & 1, pair = idx >> 16;
            A2[idx] = (h == hp) ? f2bf(PIN(42)[((pair * 2 + h) * 128 + q) * 128 + kk]) : (bf16_t)0;
        }
        for (int idx = gtid; idx < 262144; idx += GT) {
            const int l2 = idx & 255, csp = (idx >> 8) & 1, k2 = (idx >> 9) & 255, cs = idx >> 17; float sn, cn; sincos_rev((float)((k2 * l2) & 255) * (1.f / 256.f), sn, cn);
            D512[idx] = f2bf(cs == csp ? cn : (cs ? -sn : sn));
        }
        if (c >= 192) for (int idx = (c - 192) * 512 + tid; idx < 6144 * 33; idx += (G - 192) * 512) {
            const int e = idx / 6144, q = idx - e * 6144, pp = q & 63, dir = (q >> 6) & 1, g = q >> 7; const int li = (dir * 48 + g) * 64 + pp;
            const float lr = PIN(16)[li], lim = PIN(17)[li], dt = fexp(PIN(18)[dir * 48 + g]);
            if (e < 17) { const float mag = fexp(lr * dt * (float)e); float sn, cn; sincos_rev(lim * dt * (float)e * 0.15915494309189535f, sn, cn); APOW[((g * 2 + dir) * 17 + e) * 64 + pp] = (f32x2){mag * cn, mag * sn}; }
            else { const int h = e - 17; const float mag = fexp(lr * dt); float sn, cn; sincos_rev(lim * dt * 0.15915494309189535f, sn, cn);
                const float nr = mag * cn - 1.f, ni = mag * sn, den = lr * lr + lim * lim;
                const float cr = (nr * lr + ni * lim) / den, ci = (ni * lr - nr * lim) / den;
                const float br = PIN(19)[(size_t)li * 16 + h], bi = PIN(20)[(size_t)li * 16 + h]; BBT[((g * 2 + dir) * 64 + pp) * 16 + h] = (f32x2){cr * br - ci * bi, cr * bi + ci * br}; }
        }
        if (rep + 1 < REP_P0) GSYNC();
    }
    GSYNC();
#pragma unroll 1
    for (int es = 0; es < EXTRA_SYNC; ++es) GSYNC();

#pragma unroll 1
    for (int rep = 0; rep < REP_P1; ++rep) {
        PHASE_IDS
        row_pass0(p, X, HY, MOD, PIN(8), gw, NW, lane);
        if (c >= 192) FOLD_ITEMS(0, 16, (G - 192) * 8 - 1 - ((c - 192) * 8 + wave), (G - 192) * 8);
        if (c >= 192) for (int it = (c - 192) * 8 + wave; it < 512; it += (G - 192) * 8) {
            const int nb = it & 15, jb = it >> 4, g = jb >> 3, n = nb * 64 + lane;
            fold_item<64>(CSW + (size_t)(jb * 16) * 64, nullptr, PIN(15) + (size_t)(768 + g * 64) * 1024 + nb * 64, 1024, WOUT0 + (size_t)n * 1280 + 768 + jb * 16, scr, lane);
        }
        for (int idx = gtid; idx < 98304; idx += GT) {
            const int hq = idx & 3, h = (idx >> 2) & 15, j = (idx >> 6) & 15, dir = (idx >> 10) & 1, g = idx >> 11; f32x4 sm = {0.f, 0.f, 0.f, 0.f};
            const float* cre = PIN(21) + ((size_t)(dir * 48 + g) * 16 + h) * 64; const float* cim = PIN(22) + ((size_t)(dir * 48 + g) * 16 + h) * 64;
            const f32x2* ap = APOW + ((g * 2 + dir) * 17 + j) * 64; const f32x4* bb = (const f32x4*)(BBT + (size_t)((g * 2 + dir) * 64) * 16 + hq * 4);
#pragma unroll 8
            for (int pp = 0; pp < 64; ++pp) { const f32x2 a = ap[pp]; const float cr = cre[pp], ci = cim[pp]; const float er = cr * a.x - ci * a.y, ei = cr * a.y + ci * a.x;
                const f32x4 b0 = bb[pp * 8], b1 = bb[pp * 8 + 1];
                sm[0] += er * b0[0] - ei * b0[1]; sm[1] += er * b0[2] - ei * b0[3]; sm[2] += er * b1[0] - ei * b1[1]; sm[3] += er * b1[2] - ei * b1[3]; }
            *(f32x4*)(KTAB + (size_t)idx * 4) = sm;
        }
#pragma unroll 3
        for (int idx = gtid; idx < 48 * 8192; idx += GT) {
            const int p8 = (idx & 7) * 8, ri = (idx >> 3) & 1, dir = (idx >> 4) & 1, h = (idx >> 5) & 15, tau = (idx >> 9) & 15, g = idx >> 13;
            const int e = dir ? (16 - tau) : (tau + 1); const f32x4* ap = (const f32x4*)(APOW + ((g * 2 + dir) * 17 + e) * 64 + p8);
            const size_t ci = ((size_t)(dir * 48 + g) * 16 + h) * 64 + p8; const f32x4* crp = (const f32x4*)(PIN(21) + ci); const f32x4* cip = (const f32x4*)(PIN(22) + ci);
            const f32x4 a0 = ap[0], a1 = ap[1], a2 = ap[2], a3 = ap[3], cr0 = crp[0], cr1 = crp[1], ci0 = cip[0], ci1 = cip[1];
            float o[8];
            if (ri) { o[0] = -(cr0[0] * a0[1] + ci0[0] * a0[0]); o[1] = -(cr0[1] * a0[3] + ci0[1] * a0[2]); o[2] = -(cr0[2] * a1[1] + ci0[2] * a1[0]); o[3] = -(cr0[3] * a1[3] + ci0[3] * a1[2]);
                      o[4] = -(cr1[0] * a2[1] + ci1[0] * a2[0]); o[5] = -(cr1[1] * a2[3] + ci1[1] * a2[2]); o[6] = -(cr1[2] * a3[1] + ci1[2] * a3[0]); o[7] = -(cr1[3] * a3[3] + ci1[3] * a3[2]); }
            else    { o[0] = cr0[0] * a0[0] - ci0[0] * a0[1]; o[1] = cr0[1] * a0[2] - ci0[1] * a0[3]; o[2] = cr0[2] * a1[0] - ci0[2] * a1[1]; o[3] = cr0[3] * a1[2] - ci0[3] * a1[3];
                      o[4] = cr1[0] * a2[0] - ci1[0] * a2[1]; o[5] = cr1[1] * a2[2] - ci1[1] * a2[3]; o[6] = cr1[2] * a3[0] - ci1[2] * a3[1]; o[7] = cr1[3] * a3[2] - ci1[3] * a3[3]; }
            u32x4 w; w.x = pk2(o[0], o[1]); w.y = pk2(o[2], o[3]); w.z = pk2(o[4], o[5]); w.w = pk2(o[6], o[7]);
            *(u32x4*)(ME + ((size_t)g * 256 + tau * 16 + h) * 512 + 256 + dir * 128 + ri * 64 + p8) = w;
        }
#pragma unroll 3
        for (int idx = gtid; idx < 48 * 8192; idx += GT) {
            const int h8 = (idx & 1) * 8, sq = (idx >> 1) & 15, pp = (idx >> 5) & 63, ri = (idx >> 11) & 1, dir = (idx >> 12) & 1, g = idx >> 13;
            const int e = dir ? sq : (15 - sq); const f32x2 a = APOW[((g * 2 + dir) * 17 + e) * 64 + pp]; const f32x4* bp = (const f32x4*)(BBT + ((g * 2 + dir) * 64 + pp) * 16 + h8);
            const f32x4 b0 = bp[0], b1 = bp[1], b2 = bp[2], b3 = bp[3];
            float o[8];
            if (ri) { o[0] = a.x * b0[1] + a.y * b0[0]; o[1] = a.x * b0[3] + a.y * b0[2]; o[2] = a.x * b1[1] + a.y * b1[0]; o[3] = a.x * b1[3] + a.y * b1[2];
                      o[4] = a.x * b2[1] + a.y * b2[0]; o[5] = a.x * b2[3] + a.y * b2[2]; o[6] = a.x * b3[1] + a.y * b3[0]; o[7] = a.x * b3[3] + a.y * b3[2]; }
            else    { o[0] = a.x * b0[0] - a.y * b0[1]; o[1] = a.x * b0[2] - a.y * b0[3]; o[2] = a.x * b1[0] - a.y * b1[1]; o[3] = a.x * b1[2] - a.y * b1[3];
                      o[4] = a.x * b2[0] - a.y * b2[1]; o[5] = a.x * b2[2] - a.y * b2[3]; o[6] = a.x * b3[0] - a.y * b3[1]; o[7] = a.x * b3[2] - a.y * b3[3]; }
            u32x4 w; w.x = pk2(o[0], o[1]); w.y = pk2(o[2], o[3]); w.z = pk2(o[4], o[5]); w.w = pk2(o[6], o[7]);
            *(u32x4*)(SG + (size_t)idx * 8) = w;
        }
        if (rep + 1 < REP_P1) GSYNC();
    }
    GSYNC();

    {
        PHASE_IDS
#pragma unroll 3
        for (int idx = gtid; idx < 48 * 8192; idx += GT) {
            const int h8 = (idx & 1) * 8, sq = (idx >> 1) & 15, h = (idx >> 5) & 15, tau = (idx >> 9) & 15, g = idx >> 13;
            f32x4 v0 = {0.f, 0.f, 0.f, 0.f}, v1 = v0;
            if (sq <= tau) { const f32x4* k = (const f32x4*)(KTAB + (((g * 2 + 0) * 16 + (tau - sq)) * 16 + h) * 16 + h8); v0 += k[0]; v1 += k[1]; }
            if (sq >= tau) { const f32x4* k = (const f32x4*)(KTAB + (((g * 2 + 1) * 16 + (sq - tau)) * 16 + h) * 16 + h8); v0 += k[0]; v1 += k[1]; }
            if (sq == tau && (h >> 3) == (h8 >> 3)) { const float dv = p.in[23][g * 16 + h]; const int hl = h & 7;
                if (hl < 4) v0[hl] += dv; else v1[hl - 4] += dv; }
            u32x4 w; w.x = pk2(v0[0], v0[1]); w.y = pk2(v0[2], v0[3]); w.z = pk2(v1[0], v1[1]); w.w = pk2(v1[2], v1[3]);
            *(u32x4*)(ME + ((size_t)g * 256 + tau * 16 + h) * 512 + sq * 16 + h8) = w;
        }
    }
    {
        PHASE_IDS
        GJob<1024, 1024, 1024, 64, 3, 1, 0, 0> ja{HY, WIN0};
        gemm_phase(lds, ja, 0, c, G, EpiU{UH}, wv);
        GJob<1024, 1024, 1024, 1, 64, 1, 0, 0> jb{WIN0 + (size_t)768 * 1024, HY};
        gemm_phase(lds, jb, 192, c, G, EpiZt{ZT}, wv);
    }
    GSYNC();

    {
        PHASE_IDS
        for (int idx = gtid; idx < 131072; idx += GT) {
            const int l2 = idx & 255, ch = (idx >> 8) & 255, b = idx >> 16;
            const bf16_t* z = ZT + (size_t)32 * 65536 + (size_t)b * (256 * 4096) + (size_t)ch * 4096 + l2;
            float xv[16];
#pragma unroll
            for (int l1 = 0; l1 < 16; ++l1) xv[l1] = bf2f(z[256 * l1]);
            constexpr float C16[16] = {1.f, 0.92387953251f, 0.70710678119f, 0.38268343237f, 0.f, -0.38268343237f, -0.70710678119f, -0.92387953251f, -1.f, -0.92387953251f, -0.70710678119f, -0.38268343237f, 0.f, 0.38268343237f, 0.70710678119f, 0.92387953251f};
            constexpr float S16[16] = {0.f, 0.38268343237f, 0.70710678119f, 0.92387953251f, 1.f, 0.92387953251f, 0.70710678119f, 0.38268343237f, 0.f, -0.38268343237f, -0.70710678119f, -0.92387953251f, -1.f, -0.92387953251f, -0.70710678119f, -0.38268343237f};
#pragma unroll
            for (int k1 = 0; k1 < 16; ++k1) {
                float yr = 0.f, yi = 0.f;
#pragma unroll
                for (int l1 = 0; l1 < 16; ++l1) { yr += xv[l1] * C16[(l1 * k1) & 15]; yi -= xv[l1] * S16[(l1 * k1) & 15]; }
                float sn, cn; sincos_rev((float)(l2 * k1) * (1.f / 4096.f), sn, cn);
                bf16_t* o = YT + ((size_t)((b * 16 + k1) * 256 + ch)) * 512 + l2;
                o[0] = f2bf(yr * cn + yi * sn); o[256] = f2bf(yi * cn - yr * sn);
            }
        }
        if (c >= 192) CONV_ITEMS(CI1, CI6, (c - 192) * 8 + wave, (G - 192) * 8);
    }
    {
        PHASE_IDS
        GJob<512, 256, 256, 4, 1, 48, 1024 * 512, 256 * 256> js{UH, SG};
        gemm_phase(lds, js, 0, c, G, EpiState{SLOC}, wv);
    }
    {
        PHASE_IDS
        GJob<512, 256, 256, 4, 1, 48, 1024 * 512, 256 * 256> js{UH, SG};
        if (c < 192) {
            asm volatile("s_waitcnt vmcnt(0)" ::: "memory"); __syncthreads();
            Unit un; unit_at(js, c, un); const int g = un.b, pp = lane;
#define SCAN_SHORT4(DIRC) { const f32x2 a16 = APOW[((g * 2 + DIRC) * 17 + 16) * 64 + pp]; float sr[4][16], si[4][16]; \
                    _Pragma("unroll") for (int i = 0; i < 4; ++i) { const int seq = un.pm * 16 + (wave >> 1) + 4 * i; const float* __restrict__ S = SLOC + ((size_t)g * 1024 + seq * 16) * 256 + DIRC * 128 + pp; \
                        _Pragma("unroll") for (int k = 0; k < 16; ++k) { const int cc = DIRC ? (15 - k) : k; sr[i][k] = S[(size_t)cc * 256]; si[i][k] = S[(size_t)cc * 256 + 64]; } } \
                    _Pragma("unroll") for (int i = 0; i < 4; ++i) { const int seq = un.pm * 16 + (wave >> 1) + 4 * i; bf16_t* __restrict__ Hn = UH + ((size_t)g * 1024 + seq * 16) * 512 + 256 + DIRC * 128 + pp; \
                        float hr = 0.f, hi = 0.f; \
                        _Pragma("unroll") for (int k = 0; k < 16; ++k) { const int cc = DIRC ? (15 - k) : k; Hn[(size_t)cc * 512] = f2bf(hr); Hn[(size_t)cc * 512 + 64] = f2bf(hi); \
                            const float nr = a16.x * hr - a16.y * hi + sr[i][k], ni = a16.x * hi + a16.y * hr + si[i][k]; hr = nr; hi = ni; } \
                        const int oi = ((seq * 2 + DIRC) * 48 + g) * 64 + pp; p.out[(size_t)2 * NPR * DM + oi] = hr; p.out[(size_t)2 * NPR * DM + 196608 + oi] = hi; } }
#define SCAN_LONG(DIRC) { const f32x2 a16 = APOW[((g * 2 + DIRC) * 17 + 16) * 64 + pp]; f32x2 a64 = a16; \
                    _Pragma("unroll") for (int q = 0; q < 6; ++q) a64 = (f32x2){a64.x * a64.x - a64.y * a64.y, 2.f * a64.x * a64.y}; \
                    const float* __restrict__ S = SLOC + ((size_t)g * 1024 + row0 + (DIRC ? (255 - sg * 64) : sg * 64)) * 256 + DIRC * 128 + pp; \
                    bf16_t* __restrict__ Hn = UH + ((size_t)g * 1024 + row0 + (DIRC ? (255 - sg * 64) : sg * 64)) * 512 + 256 + DIRC * 128 + pp; \
                    float sr[64], si[64]; \
                    _Pragma("unroll") for (int k = 0; k < 64; ++k) { const int cc = DIRC ? -k : k; sr[k] = S[cc * 256]; si[k] = S[cc * 256 + 64]; } \
                    float er = 0.f, ei = 0.f; \
                    _Pragma("unroll") for (int k = 0; k < 64; ++k) { const float nr = a16.x * er - a16.y * ei + sr[k], ni = a16.x * ei + a16.y * er + si[k]; er = nr; ei = ni; } \
                    Eb[(wave * 64 + lane) * 2] = er; Eb[(wave * 64 + lane) * 2 + 1] = ei; \
                    __syncthreads(); \
                    const int sidx0 = ((b * 2 + DIRC) * 48 + g) * 64 + pp; float hr = p.in[2][sidx0], hi = p.in[3][sidx0]; \
                    for (int j = 0; j < sg; ++j) { const float e0 = Eb[((DIRC * 4 + j) * 64 + lane) * 2], e1 = Eb[((DIRC * 4 + j) * 64 + lane) * 2 + 1]; \
                        const float nr = a64.x * hr - a64.y * hi + e0, ni = a64.x * hi + a64.y * hr + e1; hr = nr; hi = ni; } \
                    _Pragma("unroll") for (int k = 0; k < 64; ++k) { const int cc = DIRC ? -k : k; Hn[cc * 512] = f2bf(hr); Hn[cc * 512 + 64] = f2bf(hi); \
                        const float nr = a16.x * hr - a16.y * hi + sr[k], ni = a16.x * hi + a16.y * hr + si[k]; hr = nr; hi = ni; } \
                    __syncthreads(); }
            if (un.pm < 2) {
                if (wave & 1) SCAN_SHORT4(1) else SCAN_SHORT4(0)
            } else {
                const int b = un.pm - 2, sg = wave & 3, row0 = 512 + b * 256; LAS float* Eb = (LAS float*)lds;
                if (wave >> 2) SCAN_LONG(1) else SCAN_LONG(0)
            }
#undef SCAN_SHORT4
#undef SCAN_LONG
            asm volatile("s_waitcnt vmcnt(0)" ::: "memory"); __syncthreads();
        }
    }
    {
        PHASE_IDS
        GJob<512, 512, 512, 4, 1, 48, 1024 * 512, 256 * 512> jy{UH, ME};
        gemm_phase(lds, jy, 0, c, G, EpiY{GB}, wv);
    }
    GSYNC();

    {
        PHASE_IDS
        GJob<768, 768, 768, 64, 3, 1, 0, 0> jg{GB, WGLU};
        gemm_phase(lds, jg, 0, c, G, EpiGlu{GB, p.in[25], MIX}, wv);
        if (c >= 192) {
            GJob<512, 256, 256, 2, 1, 32, 0, 65536> jp{D512, ZT};
            gemm_phase(lds, jp, 0, c - 192, 64, EpiDft{MIX, 0, 1.f / 128.f}, wv);
            GJob<512, 512, 512, 2, 1, 32, 0, 256 * 512> jsm{D512, YT};
            gemm_phase(lds, jsm, 64, c - 192, 64, EpiDft{MIX, 1, 1.f / 512.f}, wv);
        }
    }
    {
        PHASE_IDS
        (void)0;
    }
    GSYNC();

    {
        PHASE_IDS
        GJob<1280, 1280, 1280, 64, 4, 1, 0, 0> jo{MIX, WOUT0};
        RowStat s1{(float*)(ws + WS_SLOT), (unsigned*)(ws + WS_CNT) + 0 * 1024}, s2{(float*)(ws + WS_SLOT) + 65536, (unsigned*)(ws + WS_CNT) + 1 * 1024};
        gemm_phase(lds, jo, 0, c, G, EpiResNorm{X, HY, BIAS0, MOD, 2048, p.in[9], MOD, 3072, p.in[10], s1, s2, 1}, wv);
    }
    GSYNC();

#pragma unroll 1
    for (int rep = 0; rep < REP_FF1; ++rep) {
        PHASE_IDS
        GJob<1024, 1024, 1024, 64, 16, 1, 0, 0> j1{HY, WFF1};
        gemm_phase(lds, j1, 0, c, G, EpiRelu2{HMID}, wv);
        GSYNC();
    }
    {
        PHASE_IDS
        GJob<4096, 4096, 4096, 64, 4, 1, 0, 0> j2{HMID, WFF2};
        RowStat s1{(float*)(ws + WS_SLOT), (unsigned*)(ws + WS_CNT) + 2 * 1024}, s2{(float*)(ws + WS_SLOT) + 65536, (unsigned*)(ws + WS_CNT) + 3 * 1024};
        gemm_phase(lds, j2, 0, c, G, EpiResNorm{X, HY, nullptr, MOD, 5120, p.in[11], MOD + 3 * 6144, 0, p.in[30], s1, s2, 1}, wv);
    }
    GSYNC();

    {
        PHASE_IDS
        GJob<1024, 1024, 1024, 64, 6, 1, 0, 0> ji{HY, WIN1};
        gemm_phase(lds, ji, 0, c, G, EpiPlain{ZUV, 1536, nullptr, 512}, wv);
    }
    {
        PHASE_IDS
        if (c >= 384 - G) {
            constexpr int I3 = 16 * 64, I4 = 64 * 16; const int nb1 = 2 * G - 384;
            FOLD_ITEMS(16, 528, nb1 * 8 - 1 - ((c - (384 - G)) * 8 + wave), nb1 * 8);
            for (int it = (c - (384 - G)) * 8 + wave; it < I3 + I4; it += nb1 * 8) {
                if (it < I3) transpose_item(p.in[34], 4096, 4096, WFF1, 1024, 0, scr, it, lane);
                else transpose_item(p.in[35], 1024, 1024, WFF2, 4096, 0, scr, it - I3, lane);
            }
        }
    }
    GSYNC();

    {
        PHASE_IDS
        GJob<256, 256, 256, 1, 64, 2, 256 * 256, 16384 * 256> jm{A2, VT};
        if (c < 128) {
            Unit un; unit_at(jm, c, un);
            LAS bf16_t* T = (LAS bf16_t*)lds;
#pragma unroll 1
            for (int r = 0; r < 2; ++r) {
                const int chunk = 2 * un.pn + r;
                const int sub = lane >> 4, q8 = (lane & 15) * 8;
                f32x4 gA[2], gB[2], bA[2], bB[2];
#pragma unroll
                for (int hh = 0; hh < 2; ++hh) { const int h = un.b * 2 + hh; gA[hh] = *(const f32x4*)(p.in[40] + h * 128 + q8); gB[hh] = *(const f32x4*)(p.in[40] + h * 128 + q8 + 4);
                    bA[hh] = *(const f32x4*)(p.in[41] + h * 128 + q8); bB[hh] = *(const f32x4*)(p.in[41] + h * 128 + q8 + 4); }
                u32x4 rv[8];
#pragma unroll
                for (int i = 0; i < 8; ++i) { const int R = i * 32 + wave * 4 + sub, hh = i >> 2, tok = R & 127;
                    rv[i] = *(const u32x4*)(ZUV + (size_t)(chunk * 128 + tok) * 1536 + 1024 + (un.b * 2 + hh) * 128 + q8); }
#pragma unroll
                for (int i = 0; i < 8; ++i) { const int R = i * 32 + wave * 4 + sub, hh = i >> 2, tok = R & 127;
                    float x[8] = {bflo(rv[i].x), bfhi(rv[i].x), bflo(rv[i].y), bfhi(rv[i].y), bflo(rv[i].z), bfhi(rv[i].z), bflo(rv[i].w), bfhi(rv[i].w)};
                    float sm = ((x[0] + x[1]) + (x[2] + x[3])) + ((x[4] + x[5]) + (x[6] + x[7]));
                    sm += __int_as_float(__builtin_amdgcn_ds_swizzle(__float_as_int(sm), 0x041f)); sm += __int_as_float(__builtin_amdgcn_ds_swizzle(__float_as_int(sm), 0x081f));
                    sm += __int_as_float(__builtin_amdgcn_ds_swizzle(__float_as_int(sm), 0x101f)); sm += __int_as_float(__builtin_amdgcn_ds_swizzle(__float_as_int(sm), 0x201f));
                    const float mu = sm * (1.f / 128.f); float sq = 0.f;
#pragma unroll
                    for (int e = 0; e < 8; ++e) { x[e] -= mu; sq += x[e] * x[e]; }
                    sq += __int_as_float(__builtin_amdgcn_ds_swizzle(__float_as_int(sq), 0x041f)); sq += __int_as_float(__builtin_amdgcn_ds_swizzle(__float_as_int(sq), 0x081f));
                    sq += __int_as_float(__builtin_amdgcn_ds_swizzle(__float_as_int(sq), 0x101f)); sq += __int_as_float(__builtin_amdgcn_ds_swizzle(__float_as_int(sq), 0x201f));
                    const float rstd = __builtin_amdgcn_rsqf(sq * (1.f / 128.f) + EPS);
                    const f32x4 ga = gA[hh], gb = gB[hh], ba = bA[hh], bb = bB[hh];
                    u32x4 w4; w4.x = pk2(x[0] * rstd * ga[0] + ba[0], x[1] * rstd * ga[1] + ba[1]); w4.y = pk2(x[2] * rstd * ga[2] + ba[2], x[3] * rstd * ga[3] + ba[3]);
                    w4.z = pk2(x[4] * rstd * gb[0] + bb[0], x[5] * rstd * gb[1] + bb[1]); w4.w = pk2(x[6] * rstd * gb[2] + bb[2], x[7] * rstd * gb[3] + bb[3]);
                    *(LAS u32x4*)(T + (hh * 128 + tok) * 136 + q8) = w4; }
                __syncthreads();
                { const int hh = tid >> 8, seg = (tid >> 7) & 1, d = tid & 127; const LAS bf16_t* sp = T + (hh * 128 + seg * 64) * 136 + d;
                  bf16_t* dst = VT + (size_t)un.b * ((size_t)16384 * 256) + (size_t)(chunk * 128 + d) * 256 + hh * 128 + seg * 64;
#pragma unroll
                  for (int q = 0; q < 8; ++q) { u32x4 o;
                      o.x = (unsigned)sp[(q * 8 + 0) * 136] | ((unsigned)sp[(q * 8 + 1) * 136] << 16); o.y = (unsigned)sp[(q * 8 + 2) * 136] | ((unsigned)sp[(q * 8 + 3) * 136] << 16);
                      o.z = (unsigned)sp[(q * 8 + 4) * 136] | ((unsigned)sp[(q * 8 + 5) * 136] << 16); o.w = (unsigned)sp[(q * 8 + 6) * 136] | ((unsigned)sp[(q * 8 + 7) * 136] << 16);
                      *(u32x4*)(dst + q * 8) = o; } }
                __syncthreads();
            }
            asm volatile("s_waitcnt vmcnt(0)" ::: "memory");
            __syncthreads();
        } else {
            LAS bf16_t* R = (LAS bf16_t*)lds;
            for (int tile = c - 128; tile < 256; tile += 128) {
                const int token0 = tile * 64; int base, L; if (token0 < NPR) { base = token0 & ~255; L = 256; } else { base = NPR + ((token0 - NPR) & ~4095); L = 4096; }
                const int t0 = token0 - base;
                { u32x4 rv[10];
#pragma unroll
                  for (int k = 0; k < 10; ++k) { const int r = wave * 10 + k, t = t0 - 8 + r; rv[k] = (u32x4){0u, 0u, 0u, 0u};
                      if (t >= 0 && t < L) rv[k] = *(const u32x4*)(ZUV + (size_t)(base + t) * 1536 + lane * 8); }
#pragma unroll
                  for (int k = 0; k < 10; ++k) *(LAS u32x4*)(R + (wave * 10 + k) * 512 + lane * 8) = rv[k]; }
                __syncthreads();
                { const int hs = tid >> 8, cp = tid & 255, half = 1 << (cp >> 6); const LAS unsigned* Rc = (const LAS unsigned*)R + cp;
                  float s0 = 0.f, s1 = 0.f; const int i0 = hs * 32;
                  for (int r = i0 + 8 - half; r < i0 + 8 + half; ++r) { const unsigned w = Rc[r * 256]; s0 += bflo(w); s1 += bfhi(w); }
                  bf16_t* dst = MIX + (size_t)(token0 + i0) * 1024 + 2 * cp;
#pragma unroll 4
                  for (int i = i0; i < i0 + 32; ++i) { const int t = t0 + i; const int lo = (t - half) > 0 ? (t - half) : 0, hi = (t + half) < L ? (t + half) : L;
                      const unsigned wc = Rc[(i + 8) * 256]; const float inv = __builtin_amdgcn_rcpf((float)(hi - lo));
                      *(unsigned*)(dst + (size_t)(i - i0) * 1024) = pk2(s0 * inv - bflo(wc), s1 * inv - bfhi(wc));
                      const unsigned wa = Rc[(i + 8 + half) * 256], ws_ = Rc[(i + 8 - half) * 256]; s0 += bflo(wa) - bflo(ws_); s1 += bfhi(wa) - bfhi(ws_); } }
                __syncthreads();
            }
        }
        gemm_phase(lds, jm, 0, c, G, EpiGmlp{ZUV, p.in[43], MIX}, wv);
    }
    GSYNC();

    {
        PHASE_IDS
        GJob<1024, 1024, 1024, 64, 4, 1, 0, 0> jo{MIX, WOUT1};
        RowStat s1{(float*)(ws + WS_SLOT), (unsigned*)(ws + WS_CNT) + 4 * 1024}, s2{(float*)(ws + WS_SLOT) + 65536, (unsigned*)(ws + WS_CNT) + 5 * 1024};
        gemm_phase(lds, jo, 0, c, G, EpiResNorm{X, HY, nullptr, MOD + 3 * 6144, 2048, p.in[31], MOD + 3 * 6144, 3072, p.in[32], s1, s2, 1}, wv);
    }
    GSYNC();
#pragma unroll 1
    for (int rep = 0; rep < REP_FF1; ++rep) {
        PHASE_IDS
        GJob<1024, 1024, 1024, 64, 16, 1, 0, 0> j1{HY, WFF1};
        gemm_phase(lds, j1, 0, c, G, EpiRelu2{HMID}, wv);
        GSYNC();
    }
    {
        PHASE_IDS
        GJob<4096, 4096, 4096, 64, 4, 1, 0, 0> j2{HMID, WFF2};
        RowStat s1{(float*)(ws + WS_SLOT), (unsigned*)(ws + WS_CNT) + 6 * 1024}, s2{(float*)(ws + WS_SLOT) + 65536, (unsigned*)(ws + WS_CNT) + 7 * 1024};
        gemm_phase(lds, j2, 0, c, G, EpiResNorm{X, HY, nullptr, MOD + 3 * 6144, 5120, p.in[33], nullptr, 0, nullptr, s1, s2, 0}, wv);
    }
}

extern "C" void kernel_launch(void* const* d_in, const int* in_sizes, int n_in, void* d_out, int out_size, void* d_ws, size_t ws_size, hipStream_t stream) {
    static int grid_blocks = 0;
    if (grid_blocks == 0) {
        if (n_in != 44 || ws_size < WS_END) { fprintf(stderr, "kernel_launch: expected 44 inputs and >= %zu bytes of workspace, got %d / %zu\n", (size_t)WS_END, n_in, ws_size); grid_blocks = -1; return; }
        int dev = 0, cus = 0, per_cu = 0;
        (void)hipGetDevice(&dev);
        (void)hipDeviceGetAttribute(&cus, hipDeviceAttributeMultiprocessorCount, dev);
        if (hipFuncSetAttribute((const void*)mega_fwd, hipFuncAttributeMaxDynamicSharedMemorySize, LDS_BYTES) != hipSuccess) { fprintf(stderr, "kernel_launch: hipFuncSetAttribute failed\n"); grid_blocks = -1; return; }
        (void)hipOccupancyMaxActiveBlocksPerMultiprocessor(&per_cu, (const void*)mega_fwd, 512, LDS_BYTES);
        if (per_cu < 1) { fprintf(stderr, "kernel_launch: occupancy query says %d blocks per CU\n", per_cu); per_cu = 1; }
        (void)hipGetLastError();
        grid_blocks = cus;
        if (grid_blocks != 256) { fprintf(stderr, "kernel_launch: built for a 256-CU device (the fused norm epilogues need exactly 256 workgroups), got %d CUs\n", cus); grid_blocks = -1; return; }
    }
    if (grid_blocks <= 0) return;
    if (hipMemsetAsync((char*)d_ws + WS_BAR, 0, WS_ZERO_BYTES, stream) != hipSuccess) { fprintf(stderr, "kernel_launch: memset of the barrier words failed\n"); return; }
    if (hipMemsetAsync((char*)d_ws + WS_MOD, 0, 147456, stream) != hipSuccess) { fprintf(stderr, "kernel_launch: memset of the modulation accumulators failed\n"); return; }
    Params p{};
    for (int i = 0; i < 44; ++i) p.in[i] = (const float*)d_in[i];
    p.out = (float*)d_out; p.ws = (unsigned char*)d_ws;
    void* args[] = {&p};
    hipError_t e = hipLaunchCooperativeKernel((const void*)mega_fwd, dim3(grid_blocks), dim3(512), args, LDS_BYTES, stream);
    if (e != hipSuccess) fprintf(stderr, "cooperative launch failed: %s (grid %d)\n", hipGetErrorString(e), grid_blocks);
}
```
